# Optimizing an MI355X kernel written in HIP

```python
import math
import jax
import jax.numpy as jnp
from jax import lax
import numpy as np

D_MODEL = 2048
BATCH = 1
SEQ = 8192
DEPTH = 2

N_A_LAYERS = DEPTH // 2
N_B_LAYERS = DEPTH - N_A_LAYERS

GDN_QK_HEADS = 16
GDN_V_HEADS = 32
GDN_HEAD_DIM = 128
GDN_QK_DIM = GDN_QK_HEADS * GDN_HEAD_DIM
GDN_V_DIM = GDN_V_HEADS * GDN_HEAD_DIM
CONV_DIM = 2 * GDN_QK_DIM + GDN_V_DIM
GDN_PROJ = CONV_DIM + GDN_V_DIM + 2 * GDN_V_HEADS
CONV_K = 4
GDN_CHUNK = 64

FOX_HEADS = 16
FOX_KV_HEADS = 2
FOX_GROUP = FOX_HEADS // FOX_KV_HEADS
FOX_HEAD_DIM = 256
FOX_Q_DIM = FOX_HEADS * FOX_HEAD_DIM
FOX_KV_DIM = FOX_KV_HEADS * FOX_HEAD_DIM
KV_PROJ = 2 * FOX_KV_DIM + FOX_HEADS
Q_BLOCK = 128

FFN_HIDDEN = ((8 * D_MODEL // 3 + 255) // 256) * 256

NORM_EPS = 1e-6

kernel_name = "yoco_gdn_fox_adaln_trunk"


def rms_norm(x, w):
    xf = x.astype(jnp.float32)
    y = xf * lax.rsqrt(jnp.mean(xf * xf, axis=-1, keepdims=True) + NORM_EPS)
    return (y * w.astype(jnp.float32)).astype(x.dtype)


def modulate(h, shift, scale):
    return h * (1 + scale) + shift


def l2_normalize(x):
    xf = x.astype(jnp.float32)
    return xf * lax.rsqrt(jnp.sum(xf * xf, axis=-1, keepdims=True) + NORM_EPS)


def swiglu(h, w_in, w_out):
    gate, up = jnp.split(h @ w_in, 2, axis=-1)
    return (jax.nn.silu(gate) * up) @ w_out


def causal_conv(x, w):
    width = w.shape[0]
    length = x.shape[1]
    xp = jnp.pad(x, ((0, 0), (width - 1, 0), (0, 0)))
    return sum(xp[:, i:i + length] * w[i] for i in range(width))


def gated_delta_rule_chunked(q, k, v, g, beta):
    b, h, length, dk = q.shape
    dv = v.shape[-1]
    n = length // GDN_CHUNK
    blk = lambda t: t.reshape(b, h, n, GDN_CHUNK, *t.shape[3:])
    q = blk(q) * dk ** -0.5
    k = blk(k)
    v = blk(v)
    beta = blk(beta)
    g = jnp.cumsum(blk(g), axis=-1)
    causal = jnp.tril(jnp.ones((GDN_CHUNK, GDN_CHUNK), dtype=bool))
    strict = jnp.tril(jnp.ones((GDN_CHUNK, GDN_CHUNK), dtype=bool), k=-1)
    decay = jnp.exp(jnp.where(causal, g[..., :, None] - g[..., None, :], -jnp.inf))
    k_beta = k * beta[..., None]
    a_strict = jnp.where(strict, jnp.einsum('bhnid,bhnjd->bhnij', k_beta, k) * decay, 0.0)
    eye = jnp.eye(GDN_CHUNK, dtype=q.dtype)
    rhs = jnp.concatenate([v * beta[..., None], k_beta * jnp.exp(g)[..., None]], axis=-1)
    sol = lax.linalg.triangular_solve(a_strict + eye, rhs, left_side=True, lower=True,
                                      unit_diagonal=True)
    u, w = sol[..., :dv], sol[..., dv:]
    attn = jnp.where(causal, jnp.einsum('bhnid,bhnjd->bhnij', q, k) * decay, 0.0)
    g_last = g[..., -1]
    q_dec = q * jnp.exp(g)[..., None]
    k_dec = k * jnp.exp(g_last[..., None] - g)[..., None]

    def step(state, xs):
        q_c, k_c, u_c, w_c, attn_c, gl_c = xs
        v_new = u_c - jnp.einsum('bhik,bhkv->bhiv', w_c, state)
        o = jnp.einsum('bhik,bhkv->bhiv', q_c, state) + jnp.einsum('bhij,bhjv->bhiv', attn_c, v_new)
        state = state * jnp.exp(gl_c)[..., None, None] + jnp.einsum('bhik,bhiv->bhkv', k_c, v_new)
        return state, o

    xs = tuple(jnp.moveaxis(t, 2, 0) for t in (q_dec, k_dec, u, w, attn, g_last))
    s0 = jnp.zeros((b, h, dk, dv), jnp.float32)
    _, o = lax.scan(step, s0, xs)
    return jnp.moveaxis(o, 0, 2).reshape(b, h, length, dv)


def gated_deltanet(h, w_in, conv_w, a_log, dt_bias, norm_w, w_out):
    b, length, _ = h.shape
    qkv, z, beta_logit, a = jnp.split(
        h @ w_in, [CONV_DIM, CONV_DIM + GDN_V_DIM, CONV_DIM + GDN_V_DIM + GDN_V_HEADS], axis=-1)
    qkv = jax.nn.silu(causal_conv(qkv, conv_w))
    q, k, v = jnp.split(qkv, [GDN_QK_DIM, 2 * GDN_QK_DIM], axis=-1)
    rep = GDN_V_HEADS // GDN_QK_HEADS
    heads = lambda t, nh: t.reshape(b, length, nh, GDN_HEAD_DIM)
    q = jnp.repeat(l2_normalize(heads(q, GDN_QK_HEADS)), rep, axis=2)
    k = jnp.repeat(l2_normalize(heads(k, GDN_QK_HEADS)), rep, axis=2)
    v = heads(v, GDN_V_HEADS).astype(jnp.float32)
    beta = jax.nn.sigmoid(beta_logit.astype(jnp.float32))
    g = -jnp.exp(a_log.astype(jnp.float32)) * jax.nn.softplus(
        a.astype(jnp.float32) + dt_bias.astype(jnp.float32))
    tr = lambda t: jnp.swapaxes(t, 1, 2)
    o = gated_delta_rule_chunked(tr(q), tr(k), tr(v), tr(g), tr(beta))
    o = rms_norm(tr(o), norm_w) * jax.nn.silu(heads(z, GDN_V_HEADS).astype(jnp.float32))
    return o.reshape(b, length, GDN_V_DIM).astype(h.dtype) @ w_out


def shared_kv(x, cond, ada_w, ada_b, norm_w, w_kv, k_norm_w, forget_b):
    b, length, _ = x.shape
    shift, scale = (m[:, None, :] for m in jnp.split(cond @ ada_w + ada_b, 2, axis=-1))
    h = modulate(rms_norm(x, norm_w), shift, scale)
    k, v, f_logit = jnp.split(h @ w_kv, [FOX_KV_DIM, 2 * FOX_KV_DIM], axis=-1)
    k = rms_norm(k.reshape(b, length, FOX_KV_HEADS, FOX_HEAD_DIM), k_norm_w)
    v = v.reshape(b, length, FOX_KV_HEADS, FOX_HEAD_DIM)
    log_f = jax.nn.log_sigmoid(f_logit.astype(jnp.float32) + forget_b.astype(jnp.float32))
    f_cum = jnp.cumsum(log_f, axis=1).reshape(b, length, FOX_KV_HEADS, FOX_GROUP)
    return k, v, f_cum


def blocked_forgetting_softmax(q, k, v, f_cum):
    b, length, kvh, grp, hd = q.shape
    nb = length // Q_BLOCK
    qb = jnp.swapaxes(q.reshape(b, nb, Q_BLOCK, kvh, grp, hd), 0, 1)
    fb = jnp.swapaxes(f_cum.reshape(b, nb, Q_BLOCK, kvh, grp), 0, 1)
    f_k = jnp.transpose(f_cum, (0, 2, 3, 1))
    k_pos = jnp.arange(length)
    scale = hd ** -0.5

    def one_block(args):
        i, q_i, f_i = args
        s = jnp.einsum('bqhgd,bkhd->bhgqk', q_i, k, preferred_element_type=jnp.float32) * scale
        s = s + jnp.transpose(f_i, (0, 2, 3, 1))[..., None] - f_k[..., None, :]
        q_pos = i * Q_BLOCK + jnp.arange(Q_BLOCK)
        s = jnp.where(k_pos[None, :] <= q_pos[:, None], s, -jnp.inf)
        p = jax.nn.softmax(s, axis=-1).astype(v.dtype)
        return jnp.einsum('bhgqk,bkhd->bqhgd', p, v)

    o = lax.map(one_block, (jnp.arange(nb), qb, fb))
    return jnp.swapaxes(o, 0, 1).reshape(b, length, kvh, grp, hd)


def forgetting_attention(h, k, v, f_cum, w_in, q_norm_w, w_out):
    b, length, _ = h.shape
    q, gate = jnp.split(h @ w_in, 2, axis=-1)
    q = rms_norm(q.reshape(b, length, FOX_HEADS, FOX_HEAD_DIM), q_norm_w)
    q = q.reshape(b, length, FOX_KV_HEADS, FOX_GROUP, FOX_HEAD_DIM)
    o = blocked_forgetting_softmax(q, k, v, f_cum).reshape(b, length, FOX_Q_DIM)
    return (o * jax.nn.sigmoid(gate)) @ w_out


def setup_inputs(seed: int = 0) -> dict:
    key = jax.random.key(seed)
    ks = iter(jax.random.split(key, 40))
    f32 = jnp.float32

    def dense(shape, fan_in, s=1.0):
        return (s * fan_in ** -0.5) * jax.random.normal(next(ks), shape, f32)

    def gain(shape):
        return 1.0 + 0.02 * jax.random.normal(next(ks), shape, f32)

    def small(shape, s):
        return s * jax.random.normal(next(ks), shape, f32)

    d = D_MODEL
    x = jax.random.normal(next(ks), (BATCH, SEQ, d), f32)
    c = jax.random.normal(next(ks), (BATCH, d), f32)
    ada_w = dense((DEPTH, d, 6 * d), d, 0.5)
    ada_b = small((DEPTH, 6 * d), 0.02)
    norm_mix = gain((DEPTH, d))
    norm_ffn = gain((DEPTH, d))
    ffn_w_in = dense((DEPTH, d, 2 * FFN_HIDDEN), d)
    ffn_w_out = dense((DEPTH, FFN_HIDDEN, d), FFN_HIDDEN)
    gdn_w_in = dense((N_A_LAYERS, d, GDN_PROJ), d)
    gdn_conv = dense((N_A_LAYERS, CONV_K, CONV_DIM), CONV_K)
    gdn_a_log = jnp.log(jax.random.uniform(next(ks), (N_A_LAYERS, GDN_V_HEADS), f32, 1.0, 16.0))
    dt = jnp.exp(jax.random.uniform(next(ks), (N_A_LAYERS, GDN_V_HEADS), f32,
                                    math.log(1e-3), math.log(1e-1)))
    gdn_dt_bias = dt + jnp.log(-jnp.expm1(-dt))
    gdn_norm = gain((N_A_LAYERS, GDN_HEAD_DIM))
    gdn_w_out = dense((N_A_LAYERS, GDN_V_DIM, d), GDN_V_DIM)
    kv_ada_w = dense((d, 2 * d), d, 0.5)
    kv_ada_b = small((2 * d,), 0.02)
    kv_norm = gain((d,))
    kv_w = dense((d, KV_PROJ), d)
    k_norm = gain((FOX_HEAD_DIM,))
    forget_b = jax.random.uniform(next(ks), (FOX_HEADS,), f32, 1.0, 6.0)
    fox_w_in = dense((N_B_LAYERS, d, 2 * FOX_Q_DIM), d)
    q_norm = gain((N_B_LAYERS, FOX_HEAD_DIM))
    fox_w_out = dense((N_B_LAYERS, FOX_Q_DIM, d), FOX_Q_DIM)
    out_ada_w = dense((d, 2 * d), d, 0.5)
    out_ada_b = small((2 * d,), 0.02)
    out_norm = gain((d,))
    return {"x": x, "c": c, "ada_w": ada_w, "ada_b": ada_b, "norm_mix": norm_mix,
            "norm_ffn": norm_ffn, "ffn_w_in": ffn_w_in, "ffn_w_out": ffn_w_out,
            "gdn_w_in": gdn_w_in, "gdn_conv": gdn_conv, "gdn_a_log": gdn_a_log,
            "gdn_dt_bias": gdn_dt_bias, "gdn_norm": gdn_norm, "gdn_w_out": gdn_w_out,
            "kv_ada_w": kv_ada_w, "kv_ada_b": kv_ada_b, "kv_norm": kv_norm, "kv_w": kv_w,
            "k_norm": k_norm, "forget_b": forget_b, "fox_w_in": fox_w_in, "q_norm": q_norm,
            "fox_w_out": fox_w_out, "out_ada_w": out_ada_w, "out_ada_b": out_ada_b,
            "out_norm": out_norm}


def reference(x, c, ada_w, ada_b, norm_mix, norm_ffn, ffn_w_in, ffn_w_out, gdn_w_in, gdn_conv,
              gdn_a_log, gdn_dt_bias, gdn_norm, gdn_w_out, kv_ada_w, kv_ada_b, kv_norm, kv_w,
              k_norm, forget_b, fox_w_in, q_norm, fox_w_out, out_ada_w, out_ada_b, out_norm):
    cond = jax.nn.silu(c)
    k_sh = v_sh = f_sh = None
    for layer in range(DEPTH):
        sh_m, sc_m, g_m, sh_f, sc_f, g_f = (
            m[:, None, :] for m in jnp.split(cond @ ada_w[layer] + ada_b[layer], 6, axis=-1))
        h = modulate(rms_norm(x, norm_mix[layer]), sh_m, sc_m)
        if layer < N_A_LAYERS:
            y = gated_deltanet(h, gdn_w_in[layer], gdn_conv[layer], gdn_a_log[layer],
                               gdn_dt_bias[layer], gdn_norm[layer], gdn_w_out[layer])
        else:
            if layer == N_A_LAYERS:
                k_sh, v_sh, f_sh = shared_kv(x, cond, kv_ada_w, kv_ada_b, kv_norm, kv_w,
                                             k_norm, forget_b)
            j = layer - N_A_LAYERS
            y = forgetting_attention(h, k_sh, v_sh, f_sh, fox_w_in[j], q_norm[j], fox_w_out[j])
        x = x + g_m * y
        h = modulate(rms_norm(x, norm_ffn[layer]), sh_f, sc_f)
        x = x + g_f * swiglu(h, ffn_w_in[layer], ffn_w_out[layer])
    sh_o, sc_o = (m[:, None, :] for m in jnp.split(cond @ out_ada_w + out_ada_b, 2, axis=-1))
    return modulate(rms_norm(x, out_norm), sh_o, sc_o)
```

```cpp
#include <hip/hip_runtime.h>
#include <hip/hip_cooperative_groups.h>
#include <cstdio>
#include <cstdint>
namespace cg = cooperative_groups;
namespace pg8 {
#define PG8_LAS __attribute__((address_space(3)))
typedef unsigned short bf16_t;
typedef short bf16x8 __attribute__((ext_vector_type(8)));
typedef float f32x4 __attribute__((ext_vector_type(4)));
typedef unsigned u32x4 __attribute__((ext_vector_type(4)));
constexpr int BM = 256, BK = 64, HALF = 128, HTB = HALF * BK * 2  , STAGE_BYTES = 8 * HTB, NXCD = 8, WGM = 8;

__host__ __device__ __forceinline__ int lds_byte(int r, int c) { const int st = (r >> 4) * 2 + (c >> 5), rr = r & 15, cc = c & 31, ob = rr * 64 + cc * 2; return st * 1024 + (ob ^ (((ob >> 9) & 1) << 5)); }
__host__ __device__ __forceinline__ void stage_rc(int b, int& R, int& C) { const int st = b / 1024, sb = b % 1024, swz = sb ^ (((sb >> 9) & 1) << 5); R = (st >> 1) * 16 + swz / 64; C = (st & 1) * 32 + (swz % 64) / 2; }
__host__ __device__ __forceinline__ int perm32(int rho) { const int n = rho >> 4, i = rho & 15; return 8 * (i >> 2) + 4 * n + (i & 3); }

struct Unit { int pm, pn; };
struct Gemm { const bf16_t* A; const bf16_t* Bt; int M, N, K; };

struct StaticOrder {
    int nM, nN, nwg, G, c;
    __host__ __device__ void init(int M, int N, int G_, int c_) { nM = M / BM; nN = N / BM; nwg = nM * nN; G = G_; c = c_; }
    __host__ __device__ bool next(int i, Unit& u) const {
        const long L = (long)i * G + c; if (L >= nwg) return false;
        int wgid = (int)L; { const int q = nwg / NXCD, r = nwg % NXCD, xcd = wgid % NXCD, off = wgid / NXCD; wgid = (xcd < r ? xcd * (q + 1) : r * (q + 1) + (xcd - r) * q) + off; }
        const int nig = WGM * nN, gid = wgid / nig, fm = gid * WGM, gsz = (nM - fm) < WGM ? (nM - fm) : WGM;
        u.pm = fm + ((wgid % nig) % gsz); u.pn = (wgid % nig) / gsz; return true;
    }
    __device__ __forceinline__ void a_ready(const Unit&) const {}
    __device__ __forceinline__ void done(const Unit&) const {}
};
template <class Epi, class Sched, bool ALIGN_EPI = false, bool SP2 = false>
__device__ __forceinline__ void gemm_phase(PG8_LAS unsigned char* lds, const Gemm g, const Sched& S, const Epi& E) {
    int tid_ = threadIdx.x; asm volatile("" : "+v"(tid_)); const int tid = tid_, wid = __builtin_amdgcn_readfirstlane(tid >> 6), lane = tid & 63, wr = wid >> 2, wc = wid & 3, fr = lane & 15, fq = lane >> 4;
    const int K = g.K, nt = K / BK;
    unsigned voffA[2], voffB[2];
#pragma unroll
    for (int i = 0; i < 2; ++i) { int R, C; stage_rc(tid * 16 + i * 8192, R, C); const int Rb = Epi::PERM ? ((R & ~31) + perm32(R & 31)) : R;
        voffA[i] = (unsigned)(R * K + C) * 2u; voffB[i] = (unsigned)(Rb * K + C) * 2u; }
    const size_t kstep = (size_t)(BK * 2);
    const size_t hstep = (size_t)HALF * K * 2;
    const size_t tstep = 2 * hstep;
    const unsigned ldsw = (unsigned)wid * 1024u;
    const int aoff = lds_byte(wr * 64 + fr, fq * 8), boff = lds_byte(wc * 32 + fr, fq * 8);
#define PG8_SA(b, h) (((b) * 2 + (h)) * HTB)
#define PG8_SB(b, h) ((4 + (b) * 2 + (h)) * HTB)
#define PG8_STAGE(bufoff, gbase, voff) do { _Pragma("unroll") for (int _i = 0; _i < 2; ++_i) \
        __builtin_amdgcn_global_load_lds((const unsigned*)((const char*)(gbase) + (voff)[_i]), (PG8_LAS unsigned*)(lds + (bufoff) + ldsw + _i * 8192), 16, 0, 0); } while (0)
#define PG8_LDA(dst, b, h) do { _Pragma("unroll") for (int m = 0; m < 4; ++m) _Pragma("unroll") for (int k = 0; k < 2; ++k) dst[m][k] = *(const PG8_LAS bf16x8*)(lds + PG8_SA(b, h) + aoff + m * 2048 + k * 1024); } while (0)
#define PG8_LDB(dst, b, h) do { _Pragma("unroll") for (int n = 0; n < 2; ++n) _Pragma("unroll") for (int k = 0; k < 2; ++k) dst[n][k] = *(const PG8_LAS bf16x8*)(lds + PG8_SB(b, h) + boff + n * 2048 + k * 1024); } while (0)
#define PG8_MMA(ai, bj, At, Bt) do { __builtin_amdgcn_s_setprio(1); _Pragma("unroll") for (int m = 0; m < 4; ++m) _Pragma("unroll") for (int n = 0; n < 2; ++n) _Pragma("unroll") for (int k = 0; k < 2; ++k) \
        acc[ai][bj][m][n] = __builtin_amdgcn_mfma_f32_16x16x32_bf16(Bt[n][k], At[m][k], acc[ai][bj][m][n], 0, 0, 0); __builtin_amdgcn_s_setprio(0); } while (0)
#define PG8_WAIT_V(n) asm volatile("s_waitcnt vmcnt(" #n ")" ::: "memory")
#define PG8_WAIT_L(n) asm volatile("s_waitcnt lgkmcnt(" #n ")" ::: "memory")
#define PG8_BAR __builtin_amdgcn_s_barrier()
#define PG8_SCHED __builtin_amdgcn_sched_barrier(0)
    Unit cur, nxt; int ui = 0;
    if (!S.next(0, cur)) return;
    f32x4 acc[2][2][4][2];
#pragma unroll
    for (int a = 0; a < 2; ++a)
#pragma unroll
        for (int b = 0; b < 2; ++b)
#pragma unroll
            for (int m = 0; m < 4; ++m)
#pragma unroll
                for (int n = 0; n < 2; ++n) acc[a][b][m][n] = (f32x4){0.f, 0.f, 0.f, 0.f};
    bf16x8 At[4][2], B0[2][2], B1[2][2];
    const char* cA = (const char*)g.A + (size_t)cur.pm * tstep; const char* cB = (const char*)g.Bt + (size_t)cur.pn * tstep;
    S.a_ready(cur);
    if constexpr (SP2) {
        PG8_STAGE(PG8_SB(0, 0), cB, voffB); PG8_STAGE(PG8_SB(0, 1), cB + hstep, voffB); PG8_STAGE(PG8_SA(0, 0), cA, voffA); PG8_STAGE(PG8_SA(0, 1), cA + hstep, voffA);
        if (wr == 1) PG8_BAR;
        PG8_WAIT_V(2); PG8_BAR;
        PG8_STAGE(PG8_SB(1, 0), cB + kstep, voffB); PG8_STAGE(PG8_SA(1, 0), cA + kstep, voffA); PG8_STAGE(PG8_SB(1, 1), cB + hstep + kstep, voffB);
        PG8_WAIT_V(6); PG8_BAR;
    } else {
        PG8_STAGE(PG8_SB(0, 0), cB, voffB); PG8_STAGE(PG8_SA(0, 0), cA, voffA); PG8_STAGE(PG8_SB(0, 1), cB + hstep, voffB); PG8_STAGE(PG8_SA(0, 1), cA + hstep, voffA);
        if (wr == 1) PG8_BAR;
        PG8_WAIT_V(4); PG8_BAR;
        PG8_STAGE(PG8_SB(1, 0), cB + kstep, voffB); PG8_STAGE(PG8_SA(1, 0), cA + kstep, voffA); PG8_STAGE(PG8_SB(1, 1), cB + hstep + kstep, voffB);
        PG8_WAIT_V(6); PG8_BAR;
    }
    for (;;) {
        const bool has_next = S.next(ui + 1, nxt);
        const char* nA = has_next ? (const char*)g.A + (size_t)nxt.pm * tstep : cA; const char* nB = has_next ? (const char*)g.Bt + (size_t)nxt.pn * tstep : cB;
        for (int t = 0; t < nt; t += 2) {
            const bool last = (t == nt - 2);
            const char* a1 = cA + (size_t)(t + 1) * kstep;
            const char* a2 = last ? nA : cA + (size_t)(t + 2) * kstep; const char* b2 = last ? nB : cB + (size_t)(t + 2) * kstep;
            const char* a3 = a2 + kstep; const char* b3 = b2 + kstep;
            if (last && has_next) S.a_ready(nxt);
            if constexpr (SP2) {
            PG8_LDB(B0, 0, 0); PG8_LDB(B1, 0, 1); PG8_SCHED; PG8_LDA(At, 0, 0); PG8_STAGE(PG8_SA(1, 1), a1 + hstep, voffA);
            PG8_WAIT_V(8); PG8_WAIT_L(0); PG8_BAR; PG8_MMA(0, 0, At, B0); PG8_MMA(0, 1, At, B1); PG8_BAR; PG8_SCHED;
            PG8_LDA(At, 0, 1); PG8_STAGE(PG8_SB(0, 0), b2, voffB); PG8_STAGE(PG8_SB(0, 1), b2 + hstep, voffB); PG8_STAGE(PG8_SA(0, 0), a2, voffA);
            PG8_WAIT_V(8); PG8_WAIT_L(0); PG8_BAR; PG8_MMA(1, 0, At, B0); PG8_MMA(1, 1, At, B1); PG8_BAR; PG8_SCHED;
            PG8_LDB(B0, 1, 0); PG8_LDB(B1, 1, 1); PG8_SCHED; PG8_LDA(At, 1, 0); PG8_STAGE(PG8_SA(0, 1), a2 + hstep, voffA);
            PG8_WAIT_V(8); PG8_WAIT_L(0); PG8_BAR; PG8_MMA(0, 0, At, B0); PG8_MMA(0, 1, At, B1); PG8_BAR; PG8_SCHED;
            PG8_LDA(At, 1, 1); PG8_STAGE(PG8_SB(1, 0), b3, voffB); PG8_STAGE(PG8_SB(1, 1), b3 + hstep, voffB); PG8_STAGE(PG8_SA(1, 0), a3, voffA);
            PG8_WAIT_V(8); PG8_WAIT_L(0); PG8_BAR; PG8_MMA(1, 0, At, B0); PG8_MMA(1, 1, At, B1); PG8_BAR; PG8_SCHED;
            } else {
            PG8_LDB(B0, 0, 0); PG8_SCHED; PG8_LDA(At, 0, 0); PG8_STAGE(PG8_SA(1, 1), a1 + hstep, voffA);
            PG8_WAIT_L(8); PG8_BAR; PG8_WAIT_L(0); PG8_MMA(0, 0, At, B0); PG8_BAR; PG8_SCHED;
            PG8_LDB(B1, 0, 1); PG8_STAGE(PG8_SB(0, 0), b2, voffB);
            PG8_BAR; PG8_WAIT_L(0); PG8_MMA(0, 1, At, B1); PG8_BAR;
            PG8_LDA(At, 0, 1); PG8_STAGE(PG8_SA(0, 0), a2, voffA);
            PG8_BAR; PG8_WAIT_L(0); PG8_MMA(1, 0, At, B0); PG8_BAR; PG8_SCHED;
            PG8_STAGE(PG8_SB(0, 1), b2 + hstep, voffB);
            PG8_WAIT_V(6); PG8_BAR; PG8_MMA(1, 1, At, B1); PG8_BAR;
            PG8_LDB(B0, 1, 0); PG8_SCHED; PG8_LDA(At, 1, 0); PG8_STAGE(PG8_SA(0, 1), a2 + hstep, voffA);
            PG8_WAIT_L(8); PG8_BAR; PG8_WAIT_L(0); PG8_MMA(0, 0, At, B0); PG8_BAR; PG8_SCHED;
            PG8_LDB(B1, 1, 1); PG8_STAGE(PG8_SB(1, 0), b3, voffB);
            PG8_BAR; PG8_WAIT_L(0); PG8_MMA(0, 1, At, B1); PG8_BAR;
            PG8_LDA(At, 1, 1); PG8_STAGE(PG8_SA(1, 0), a3, voffA);
            PG8_BAR; PG8_WAIT_L(0); PG8_MMA(1, 0, At, B0); PG8_BAR; PG8_SCHED;
            PG8_STAGE(PG8_SB(1, 1), b3 + hstep, voffB);
            PG8_WAIT_V(6); PG8_BAR; PG8_MMA(1, 1, At, B1); PG8_BAR;
            }
        }
        if constexpr (ALIGN_EPI) { if (wr == 0) PG8_BAR; }
        if constexpr (!Epi::AFTER_DRAIN) { E(acc, cur, wr, wc, fr, fq); S.done(cur); }
        if (!has_next) break;
#pragma unroll
        for (int a = 0; a < 2; ++a)
#pragma unroll
            for (int b = 0; b < 2; ++b)
#pragma unroll
                for (int m = 0; m < 4; ++m)
#pragma unroll
                    for (int n = 0; n < 2; ++n) acc[a][b][m][n] = (f32x4){0.f, 0.f, 0.f, 0.f};
        cur = nxt; cA = nA; cB = nB; ++ui;
        if constexpr (ALIGN_EPI) { if (wr == 1) PG8_BAR; }
    }
    PG8_WAIT_V(0);
    if constexpr (!ALIGN_EPI) { if (wr == 0) PG8_BAR; }
    PG8_BAR;
    if constexpr (Epi::AFTER_DRAIN) { E.fused(acc, cur, wr, wc, fr, fq, lds, wid, lane); S.done(cur); }
#undef PG8_SA
#undef PG8_SB
#undef PG8_STAGE
#undef PG8_LDA
#undef PG8_LDB
#undef PG8_MMA
#undef PG8_WAIT_V
#undef PG8_WAIT_L
#undef PG8_BAR
#undef PG8_SCHED
}
}

using pg8::bf16_t; using pg8::bf16x8; using pg8::f32x4; using pg8::u32x4; using pg8::Unit;
typedef unsigned u32x2 __attribute__((ext_vector_type(2)));
typedef float f32x2 __attribute__((ext_vector_type(2)));
#define DI __device__ __forceinline__

constexpr int L_ = 8192, D_ = 2048;
constexpr int NTHR = 512;
constexpr int LDS_BYTES = 155648 + 256;

constexpr size_t O_WGIN = 0;
constexpr size_t O_WGOUT = O_WGIN + (size_t)12544 * 2048 * 2;
constexpr size_t SZ_WFIN = (size_t)11264 * 2048 * 2;
constexpr size_t O_WFIN = O_WGOUT + (size_t)2048 * 4096 * 2;
constexpr size_t SZ_WFOUT = (size_t)2048 * 5632 * 2;
constexpr size_t O_WFOUT = O_WFIN + 2 * SZ_WFIN;
constexpr size_t O_WKV = O_WFOUT + 2 * SZ_WFOUT;
constexpr size_t O_WXIN = O_WKV + (size_t)1280 * 2048 * 2;
constexpr size_t O_WXOUT = O_WXIN + (size_t)8192 * 2048 * 2;
constexpr size_t O_MODP = O_WXOUT + (size_t)2048 * 4096 * 2;
constexpr size_t O_MOD = O_MODP + (size_t)16 * 32768 * 4;
constexpr size_t O_SMALL = O_MOD + (size_t)32768 * 4;
constexpr size_t O_XS = O_SMALL + (size_t)65536 * 4;
constexpr size_t O_H = O_XS + (size_t)L_ * 2048 * 4;
constexpr size_t O_H2 = O_H + (size_t)L_ * 2048 * 2;
constexpr size_t O_BIG = O_H2 + (size_t)L_ * 2048 * 2;
constexpr size_t O_QKVRAW = O_BIG;
constexpr size_t O_Z = O_QKVRAW + (size_t)L_ * 8192 * 2;
constexpr size_t O_BA = O_Z + (size_t)L_ * 4096 * 2;
constexpr size_t O_KN = O_BA + (size_t)L_ * 64 * 4;
constexpr size_t O_QN = O_KN + (size_t)L_ * 2048 * 4;
constexpr size_t O_VV = O_QN + (size_t)L_ * 2048 * 2;
constexpr size_t O_BETA = O_VV + (size_t)L_ * 4096 * 2;
constexpr size_t O_GG = O_BETA + (size_t)L_ * 32 * 4;
constexpr size_t O_GDN_END = O_GG + (size_t)L_ * 32 * 4;
constexpr size_t O_PA_HK = O_XS;
constexpr size_t O_PA_HV = O_KN;
constexpr size_t O_PA_G = O_GDN_END;
constexpr size_t O_PA_END = O_PA_G + (size_t)4096 * 192 * 4;
static_assert(O_PA_HV + (size_t)4096 * 40960 <= O_BETA, "PA_HV overflows");
constexpr size_t O_ORAW = O_H;
constexpr size_t O_OG = O_QKVRAW;
constexpr size_t O_HID = O_BIG;
constexpr size_t O_QRAW = O_BIG;
constexpr size_t O_GSIG = O_QRAW + (size_t)L_ * 4096 * 2;
constexpr size_t O_KVRAW = O_GSIG + (size_t)L_ * 4096 * 2;
constexpr size_t O_KB = O_KVRAW + (size_t)L_ * 1280 * 4;
constexpr size_t O_VB = O_KB + (size_t)L_ * 512 * 2;
constexpr size_t O_FCUM = O_VB + (size_t)L_ * 512 * 2;
constexpr size_t O_OG2 = O_FCUM + (size_t)L_ * 16 * 4;
constexpr size_t O_FOX_END = O_OG2 + (size_t)L_ * 4096 * 2;
constexpr size_t WS_NEED = O_PA_END > O_FOX_END ? O_PA_END : O_FOX_END;

constexpr size_t O_BARCTR = O_SMALL + (size_t)48000 * 4;
constexpr int S_NORM_MIX = 0, S_NORM_FFN = 4096, S_CONV = 8192, S_ALOG = 40960, S_DTB = 41024, S_GNORM = 41088, S_KVNORM = 41216, S_KNORM = 43264, S_FB = 43520, S_QNORM = 43584, S_ONORM = 43840;
struct Params {
    const float *x, *c, *ada_w, *ada_b, *norm_mix, *norm_ffn, *ffn_w_in, *ffn_w_out, *gdn_w_in, *gdn_conv, *gdn_a_log, *gdn_dt_bias, *gdn_norm, *gdn_w_out,
        *kv_ada_w, *kv_ada_b, *kv_norm, *kv_w, *k_norm, *forget_b, *fox_w_in, *q_norm, *fox_w_out, *out_ada_w, *out_ada_b, *out_norm;
    float* out; unsigned char* ws;
};

DI f32x4 mfma16(bf16x8 a, bf16x8 b, f32x4 c) { return __builtin_amdgcn_mfma_f32_16x16x32_bf16(a, b, c, 0, 0, 0); }
DI int ltid() { int t = threadIdx.x; asm volatile("" : "+v"(t)); return t; }
DI unsigned pk2(float lo, float hi) { unsigned r; asm volatile("v_cvt_pk_bf16_f32 %0, %1, %2" : "=v"(r) : "v"(lo), "v"(hi)); return r; }
DI float bf2f(bf16_t b) { return __uint_as_float(((unsigned)b) << 16); }
DI float bflo(unsigned w) { return __uint_as_float(w << 16); }
DI float bfhi(unsigned w) { return __uint_as_float(w & 0xffff0000u); }
DI float wave_sum(float v) { v += __shfl_xor(v, 32); v += __shfl_xor(v, 16); v += __shfl_xor(v, 8); v += __shfl_xor(v, 4); v += __shfl_xor(v, 2); v += __shfl_xor(v, 1); return v; }
DI float wave_max(float v) { v = fmaxf(v, __shfl_xor(v, 32)); v = fmaxf(v, __shfl_xor(v, 16)); v = fmaxf(v, __shfl_xor(v, 8)); v = fmaxf(v, __shfl_xor(v, 4)); v = fmaxf(v, __shfl_xor(v, 2)); v = fmaxf(v, __shfl_xor(v, 1)); return v; }
DI float siluf(float x) { return x / (1.0f + expf(-x)); }
DI float sigmf(float x) { return 1.0f / (1.0f + expf(-x)); }
DI float sigm_fast(float x) { return __builtin_amdgcn_rcpf(1.0f + __builtin_amdgcn_exp2f(-1.4426950408889634f * x)); }
DI float silu_fast(float x) { return x * sigm_fast(x); }
DI float softplusf(float x) { return fmaxf(x, 0.f) + log1pf(expf(-fabsf(x))); }

struct EpiGdnIn {
    static constexpr bool PERM = true, AFTER_DRAIN = false;
    bf16_t* qkv; bf16_t* z; float* ba;
    DI void operator()(const f32x4 (&acc)[2][2][4][2], const Unit& u, int wr, int wc, int fr, int fq) const {
        const int row0 = u.pm * 256 + wr * 64 + fr;
        if (u.pn < 48) {
            bf16_t* base; int ldc, colt;
            if (u.pn < 32) { base = qkv; ldc = 8192; colt = u.pn * 256; } else { base = z; ldc = 4096; colt = (u.pn - 32) * 256; }
            const int col0 = colt + wc * 32 + 8 * fq;
#pragma unroll
            for (int ai = 0; ai < 2; ++ai)
#pragma unroll
                for (int m = 0; m < 4; ++m) { bf16_t* rowp = base + (size_t)(row0 + ai * 128 + m * 16) * ldc + col0;
#pragma unroll
                    for (int bj = 0; bj < 2; ++bj) { const f32x4 v0 = acc[ai][bj][m][0], v1 = acc[ai][bj][m][1];
                        u32x4 w; w.x = pk2(v0[0], v0[1]); w.y = pk2(v0[2], v0[3]); w.z = pk2(v1[0], v1[1]); w.w = pk2(v1[2], v1[3]);
                        *(u32x4*)(rowp + bj * 128) = w; } }
        } else if (wc < 2) {
#pragma unroll
            for (int ai = 0; ai < 2; ++ai)
#pragma unroll
                for (int m = 0; m < 4; ++m) { float* rowp = ba + (size_t)(row0 + ai * 128 + m * 16) * 64 + wc * 32 + 8 * fq;
                    *(f32x4*)rowp = acc[ai][0][m][0]; *(f32x4*)(rowp + 4) = acc[ai][0][m][1]; }
        }
    }
};
struct EpiResid {
    static constexpr bool PERM = false, AFTER_DRAIN = false;
    const float* base; float* out; const float* gate;
    DI void operator()(const f32x4 (&acc)[2][2][4][2], const Unit& u, int wr, int wc, int fr, int fq) const {
        const int row0 = u.pm * 256 + wr * 64 + fr, col0 = u.pn * 256 + wc * 32 + 4 * fq;
        f32x4 gv[2][2];
#pragma unroll
        for (int bj = 0; bj < 2; ++bj)
#pragma unroll
            for (int n = 0; n < 2; ++n) gv[bj][n] = *(const f32x4*)(gate + col0 + bj * 128 + n * 16);
#pragma unroll
        for (int ai = 0; ai < 2; ++ai)
#pragma unroll
            for (int m = 0; m < 4; ++m) { const size_t off = (size_t)(row0 + ai * 128 + m * 16) * 2048 + col0;
#pragma unroll
                for (int bj = 0; bj < 2; ++bj)
#pragma unroll
                    for (int n = 0; n < 2; ++n) { const f32x4 b = *(const f32x4*)(base + off + bj * 128 + n * 16);
                        *(f32x4*)(out + off + bj * 128 + n * 16) = b + gv[bj][n] * acc[ai][bj][m][n]; } }
    }
};
struct EpiSwiglu {
    static constexpr bool PERM = true, AFTER_DRAIN = false;
    bf16_t* hid;
    DI void operator()(const f32x4 (&acc)[2][2][4][2], const Unit& u, int wr, int wc, int fr, int fq) const {
        const int row0 = u.pm * 256 + wr * 64 + fr, col0 = u.pn * 128 + wc * 32 + 8 * fq;
#pragma unroll
        for (int ai = 0; ai < 2; ++ai)
#pragma unroll
            for (int m = 0; m < 4; ++m) { bf16_t* rowp = hid + (size_t)(row0 + ai * 128 + m * 16) * 5632 + col0;
                const f32x4 g0 = acc[ai][0][m][0], g1 = acc[ai][0][m][1], u0 = acc[ai][1][m][0], u1 = acc[ai][1][m][1];
                float h[8];
#pragma unroll
                for (int j = 0; j < 4; ++j) { h[j] = silu_fast(g0[j]) * u0[j]; h[4 + j] = silu_fast(g1[j]) * u1[j]; }
                u32x4 w; w.x = pk2(h[0], h[1]); w.y = pk2(h[2], h[3]); w.z = pk2(h[4], h[5]); w.w = pk2(h[6], h[7]);
                *(u32x4*)rowp = w; }
    }
};
struct EpiKV {
    static constexpr bool PERM = false, AFTER_DRAIN = false;
    float* kv;
    DI void operator()(const f32x4 (&acc)[2][2][4][2], const Unit& u, int wr, int wc, int fr, int fq) const {
        const int row0 = u.pm * 256 + wr * 64 + fr, col0 = u.pn * 256 + wc * 32 + 4 * fq;
#pragma unroll
        for (int ai = 0; ai < 2; ++ai)
#pragma unroll
            for (int m = 0; m < 4; ++m) { float* rowp = kv + (size_t)(row0 + ai * 128 + m * 16) * 1280 + col0;
#pragma unroll
                for (int bj = 0; bj < 2; ++bj)
#pragma unroll
                    for (int n = 0; n < 2; ++n) *(f32x4*)(rowp + bj * 128 + n * 16) = acc[ai][bj][m][n]; }
    }
};
struct EpiFoxIn {
    static constexpr bool PERM = true, AFTER_DRAIN = false;
    bf16_t* qraw; bf16_t* gsig;
    DI void operator()(const f32x4 (&acc)[2][2][4][2], const Unit& u, int wr, int wc, int fr, int fq) const {
        const int row0 = u.pm * 256 + wr * 64 + fr;
        const bool isg = u.pn >= 16;
        bf16_t* base = isg ? gsig : qraw;
        const int col0 = (isg ? u.pn - 16 : u.pn) * 256 + wc * 32 + 8 * fq;
#pragma unroll
        for (int ai = 0; ai < 2; ++ai)
#pragma unroll
            for (int m = 0; m < 4; ++m) { bf16_t* rowp = base + (size_t)(row0 + ai * 128 + m * 16) * 4096 + col0;
#pragma unroll
                for (int bj = 0; bj < 2; ++bj) { f32x4 v0 = acc[ai][bj][m][0], v1 = acc[ai][bj][m][1];
                    if (isg) {
#pragma unroll
                        for (int j = 0; j < 4; ++j) { v0[j] = sigm_fast(v0[j]); v1[j] = sigm_fast(v1[j]); } }
                    u32x4 w; w.x = pk2(v0[0], v0[1]); w.y = pk2(v0[2], v0[3]); w.z = pk2(v1[0], v1[1]); w.w = pk2(v1[2], v1[3]);
                    *(u32x4*)(rowp + bj * 128) = w; } }
    }
};

template <class Epi>
DI void run_gemm(unsigned char* lds, const bf16_t* A, const bf16_t* Bt, int N, int K, const Epi& E) {
    pg8::Gemm g{A, Bt, L_, N, K};
    int bid_ = blockIdx.x, gd_ = gridDim.x; asm volatile("" : "+s"(bid_), "+s"(gd_));
    pg8::StaticOrder S; S.init(L_, N, gd_, bid_);
    pg8::gemm_phase<Epi, pg8::StaticOrder, true, true>((PG8_LAS unsigned char*)lds, g, S, E);
    __syncthreads();
}

DI void phase_ba(const bf16_t* H, const bf16_t* Wt, float* ba) { const int TIDX = ltid();
    const int wid = TIDX >> 6, lane = TIDX & 63, l15 = lane & 15, quad = lane >> 4;
    for (int item = blockIdx.x; item < 256; item += gridDim.x) {
        const bf16_t* ap = H + (size_t)(item * 32 + (wid >> 2) * 16 + l15) * 2048 + quad * 8;
        const bf16_t* bp = Wt + (size_t)(12288 + (wid & 3) * 16 + l15) * 2048 + quad * 8;
        f32x4 acc0 = (f32x4){0.f, 0.f, 0.f, 0.f}, acc1 = acc0;
#pragma unroll 4
        for (int k = 0; k < 2048; k += 64) {
            const bf16x8 a0 = *(const bf16x8*)(ap + k), b0 = *(const bf16x8*)(bp + k), a1 = *(const bf16x8*)(ap + k + 32), b1 = *(const bf16x8*)(bp + k + 32);
            acc0 = mfma16(a0, b0, acc0); acc1 = mfma16(a1, b1, acc1); }
        acc0 += acc1;
        float* op = ba + (size_t)(item * 32 + (wid >> 2) * 16 + quad * 4) * 64 + (wid & 3) * 16 + l15;
#pragma unroll
        for (int j = 0; j < 4; ++j) op[j * 64] = acc0[j];
    }
}

struct WD { const float* src; bf16_t* dst; int K, N, Npad, mode; };
DI WD get_wd(const Params& p, int i) {
    unsigned char* ws = p.ws;
    switch (i) {
        case 0: return WD{p.gdn_w_in, (bf16_t*)(ws + O_WGIN), 2048, 12352, 12544, 0};
        case 1: return WD{p.gdn_w_out, (bf16_t*)(ws + O_WGOUT), 4096, 2048, 2048, 0};
        case 2: return WD{p.ffn_w_in, (bf16_t*)(ws + O_WFIN), 2048, 11264, 11264, 1};
        case 3: return WD{p.ffn_w_in + (size_t)2048 * 11264, (bf16_t*)(ws + O_WFIN + SZ_WFIN), 2048, 11264, 11264, 1};
        case 4: return WD{p.ffn_w_out, (bf16_t*)(ws + O_WFOUT), 5632, 2048, 2048, 0};
        case 5: return WD{p.ffn_w_out + (size_t)5632 * 2048, (bf16_t*)(ws + O_WFOUT + SZ_WFOUT), 5632, 2048, 2048, 0};
        case 6: return WD{p.kv_w, (bf16_t*)(ws + O_WKV), 2048, 1040, 1280, 0};
        case 7: return WD{p.fox_w_in, (bf16_t*)(ws + O_WXIN), 2048, 8192, 8192, 0};
        default: return WD{p.fox_w_out, (bf16_t*)(ws + O_WXOUT), 4096, 2048, 2048, 0};
    }
}
DI int wrow(int n, int mode) {
    if (mode == 1) { if (n < 5632) return (n >> 7) * 256 + (n & 127); const int m = n - 5632; return (m >> 7) * 256 + 128 + (m & 127); }
    return n;
}
DI void convert_load(const WD& d, int j, int tid, f32x4 (&v)[2]) {
    const int nkt = d.K / 64, k0 = (j % nkt) * 64, n0 = (j / nkt) * 64;
#pragma unroll
    for (int i = 0; i < 2; ++i) { const int kk = (tid >> 4) + i * 32, n4 = (tid & 15) * 4;
        v[i] = (f32x4){0.f, 0.f, 0.f, 0.f};
        if (n0 + n4 < d.N) v[i] = *(const f32x4*)(d.src + (size_t)(k0 + kk) * d.N + n0 + n4); }
}
DI void convert_store(const WD& d, int j, int tid, const f32x4 (&v)[2], float* tile  ) {
    const int nkt = d.K / 64, k0 = (j % nkt) * 64, n0 = (j / nkt) * 64;
    __syncthreads();
#pragma unroll
    for (int i = 0; i < 2; ++i) { const int kk = (tid >> 4) + i * 32, n4 = (tid & 15) * 4;
        tile[(n4 + 0) * 65 + kk] = v[i][0]; tile[(n4 + 1) * 65 + kk] = v[i][1]; tile[(n4 + 2) * 65 + kk] = v[i][2]; tile[(n4 + 3) * 65 + kk] = v[i][3]; }
    __syncthreads();
    const int n = tid >> 3, k8 = (tid & 7) * 8;
    const float* r = tile + n * 65 + k8;
    u32x4 w; w.x = pk2(r[0], r[1]); w.y = pk2(r[2], r[3]); w.z = pk2(r[4], r[5]); w.w = pk2(r[6], r[7]);
    *(u32x4*)(d.dst + (size_t)wrow(n0 + n, d.mode) * d.K + k0 + k8) = w;
}
DI void phase_convert(const Params& p, unsigned char* lds, int bid, int nb, int dlo, int dhi) { const int TIDX = ltid();
    float* tile = (float*)lds;
    int base = 0;
    for (int i = dlo; i < dhi; ++i) {
        const WD d = get_wd(p, i);
        const int cnt = (d.K / 64) * (d.Npad / 64);
        int first = bid - (base % nb); if (first < 0) first += nb;
        f32x4 va[2], vb[2];
        int j = first;
        if (j < cnt) convert_load(d, j, TIDX, va);
        for (; j < cnt; j += 2 * nb) {
            const int j2 = j + nb, j3 = j2 + nb;
            if (j2 < cnt) convert_load(d, j2, TIDX, vb);
            convert_store(d, j, TIDX, va, tile);
            if (j3 < cnt) convert_load(d, j3, TIDX, va);
            if (j2 < cnt) convert_store(d, j2, TIDX, vb, tile);
        }
        base += cnt;
    }
    __syncthreads();
}
DI void phase_adaln(const Params& p, unsigned char* lds, int bid, int nb, int cb0, int ncb) { const int TIDX = ltid();
    float* cs = (float*)lds;
    float* modp = (float*)(p.ws + O_MODP);
    for (int item = bid; item < ncb * 16; item += nb) {
        const int cb = cb0 + item % ncb, ks = item / ncb;
        const int col = cb * 512 + TIDX;
        const float* W; int Nm, jm;
        if (col < 24576) { const int l = col >= 12288 ? 1 : 0; W = p.ada_w + (size_t)l * 2048 * 12288; Nm = 12288; jm = col - l * 12288; }
        else if (col < 28672) { W = p.kv_ada_w; Nm = 4096; jm = col - 24576; }
        else { W = p.out_ada_w; Nm = 4096; jm = col - 28672; }
        __syncthreads();
        if (TIDX < 128) cs[TIDX] = siluf(p.c[ks * 128 + TIDX]);
        __syncthreads();
        const float* wp = W + (size_t)(ks * 128) * Nm + jm;
        float a0 = 0.f, a1 = 0.f, a2 = 0.f, a3 = 0.f;
#pragma unroll 1
        for (int k0 = 0; k0 < 128; k0 += 32) {
            float wv[32];
#pragma unroll
            for (int k = 0; k < 32; ++k) wv[k] = wp[(size_t)(k0 + k) * Nm];
#pragma unroll
            for (int k = 0; k < 32; k += 4) { a0 += cs[k0 + k] * wv[k]; a1 += cs[k0 + k + 1] * wv[k + 1]; a2 += cs[k0 + k + 2] * wv[k + 2]; a3 += cs[k0 + k + 3] * wv[k + 3]; }
        }
        modp[ks * 32768 + col] = (a0 + a1) + (a2 + a3);
    }
    __syncthreads();
}
DI void copy_vec(const float* src, float* dst, int n) { const int TIDX = ltid(); for (int i = blockIdx.x * NTHR + TIDX; i < n; i += gridDim.x * NTHR) dst[i] = src[i]; }
DI void phase_copysmall(const Params& p) {
    float* sm = (float*)(p.ws + O_SMALL);
    copy_vec(p.norm_mix, sm + S_NORM_MIX, 4096); copy_vec(p.norm_ffn, sm + S_NORM_FFN, 4096); copy_vec(p.gdn_conv, sm + S_CONV, 32768);
    copy_vec(p.gdn_a_log, sm + S_ALOG, 32); copy_vec(p.gdn_dt_bias, sm + S_DTB, 32); copy_vec(p.gdn_norm, sm + S_GNORM, 128);
    copy_vec(p.kv_norm, sm + S_KVNORM, 2048); copy_vec(p.k_norm, sm + S_KNORM, 256); copy_vec(p.forget_b, sm + S_FB, 16);
    copy_vec(p.q_norm, sm + S_QNORM, 256); copy_vec(p.out_norm, sm + S_ONORM, 2048);
}
DI void phase_modreduce(const Params& p, int col0, int col1) { const int TIDX = ltid();
    const float* modp = (const float*)(p.ws + O_MODP);
    float* mod = (float*)(p.ws + O_MOD);
    for (int col = col0 + blockIdx.x * NTHR + TIDX; col < col1; col += gridDim.x * NTHR) {
        float s = col < 24576 ? p.ada_b[col] : (col < 28672 ? p.kv_ada_b[col - 24576] : p.out_ada_b[col - 28672]);
#pragma unroll
        for (int k = 0; k < 16; ++k) s += modp[k * 32768 + col];
        mod[col] = s;
    }
}

DI void phase_normmod(const float* x, const float* w1, const float* sh1, const float* sc1, bf16_t* o1,
                      const float* w2, const float* sh2, const float* sc2, bf16_t* o2, float* xcopy = nullptr) { const int TIDX = ltid();
    const int wid = TIDX >> 6, lane = TIDX & 63;
    for (int r = (blockIdx.x * 8 + wid) * 2; r < L_; r += gridDim.x * 16) {
        const float* xr = x + (size_t)r * 2048;
        f32x4 va[8], vb[8]; float sa = 0.f, sb = 0.f;
#pragma unroll
        for (int i = 0; i < 8; ++i) { va[i] = *(const f32x4*)(xr + i * 256 + lane * 4); vb[i] = *(const f32x4*)(xr + 2048 + i * 256 + lane * 4); }
#pragma unroll
        for (int i = 0; i < 8; ++i) { sa += va[i][0] * va[i][0] + va[i][1] * va[i][1] + va[i][2] * va[i][2] + va[i][3] * va[i][3];
                                      sb += vb[i][0] * vb[i][0] + vb[i][1] * vb[i][1] + vb[i][2] * vb[i][2] + vb[i][3] * vb[i][3]; }
#pragma unroll
        for (int d = 32; d >= 1; d >>= 1) { sa += __shfl_xor(sa, d); sb += __shfl_xor(sb, d); }
        const float ra = 1.0f / sqrtf(sa * (1.0f / 2048.0f) + 1e-6f), rb = 1.0f / sqrtf(sb * (1.0f / 2048.0f) + 1e-6f);
        if (xcopy) {
#pragma unroll
            for (int i = 0; i < 8; ++i) { *(f32x4*)(xcopy + (size_t)r * 2048 + i * 256 + lane * 4) = va[i]; *(f32x4*)(xcopy + (size_t)(r + 1) * 2048 + i * 256 + lane * 4) = vb[i]; } }
#pragma unroll
        for (int i = 0; i < 8; ++i) { const int c = i * 256 + lane * 4;
            const f32x4 wv = *(const f32x4*)(w1 + c), sh = *(const f32x4*)(sh1 + c), sc = *(const f32x4*)(sc1 + c) + 1.0f;
            const f32x4 ya = (va[i] * ra * wv) * sc + sh, yb = (vb[i] * rb * wv) * sc + sh;
            u32x2 oa; oa.x = pk2(ya[0], ya[1]); oa.y = pk2(ya[2], ya[3]); u32x2 ob; ob.x = pk2(yb[0], yb[1]); ob.y = pk2(yb[2], yb[3]);
            *(u32x2*)(o1 + (size_t)r * 2048 + c) = oa; *(u32x2*)(o1 + (size_t)(r + 1) * 2048 + c) = ob; }
        if (o2) {
#pragma unroll
            for (int i = 0; i < 8; ++i) { const int c = i * 256 + lane * 4;
                const f32x4 wv = *(const f32x4*)(w2 + c), sh = *(const f32x4*)(sh2 + c), sc = *(const f32x4*)(sc2 + c) + 1.0f;
                const f32x4 ya = (va[i] * ra * wv) * sc + sh, yb = (vb[i] * rb * wv) * sc + sh;
                u32x2 oa; oa.x = pk2(ya[0], ya[1]); oa.y = pk2(ya[2], ya[3]); u32x2 ob; ob.x = pk2(yb[0], yb[1]); ob.y = pk2(yb[2], yb[3]);
                *(u32x2*)(o2 + (size_t)r * 2048 + c) = oa; *(u32x2*)(o2 + (size_t)(r + 1) * 2048 + c) = ob; }
        }
    }
}
DI void phase_final(const float* x, const float* w1, const float* sh1, const float* sc1, float* out) { const int TIDX = ltid();
    const int wid = TIDX >> 6, lane = TIDX & 63;
    for (int r = (blockIdx.x * 8 + wid) * 2; r < L_; r += gridDim.x * 16) {
        const float* xr = x + (size_t)r * 2048;
        f32x4 va[8], vb[8]; float sa = 0.f, sb = 0.f;
#pragma unroll
        for (int i = 0; i < 8; ++i) { va[i] = *(const f32x4*)(xr + i * 256 + lane * 4); vb[i] = *(const f32x4*)(xr + 2048 + i * 256 + lane * 4); }
#pragma unroll
        for (int i = 0; i < 8; ++i) { sa += va[i][0] * va[i][0] + va[i][1] * va[i][1] + va[i][2] * va[i][2] + va[i][3] * va[i][3];
                                      sb += vb[i][0] * vb[i][0] + vb[i][1] * vb[i][1] + vb[i][2] * vb[i][2] + vb[i][3] * vb[i][3]; }
#pragma unroll
        for (int d = 32; d >= 1; d >>= 1) { sa += __shfl_xor(sa, d); sb += __shfl_xor(sb, d); }
        const float ra = 1.0f / sqrtf(sa * (1.0f / 2048.0f) + 1e-6f), rb = 1.0f / sqrtf(sb * (1.0f / 2048.0f) + 1e-6f);
#pragma unroll
        for (int i = 0; i < 8; ++i) { const int c = i * 256 + lane * 4;
            const f32x4 wv = *(const f32x4*)(w1 + c), sh = *(const f32x4*)(sh1 + c), sc = *(const f32x4*)(sc1 + c) + 1.0f;
            *(f32x4*)(out + (size_t)r * 2048 + c) = (va[i] * ra * wv) * sc + sh; *(f32x4*)(out + (size_t)(r + 1) * 2048 + c) = (vb[i] * rb * wv) * sc + sh; }
    }
}

DI void phase_conv(const Params& p) { const int TIDX = ltid();
    const bf16_t* raw = (const bf16_t*)(p.ws + O_QKVRAW);
    const float* ba = (const float*)(p.ws + O_BA);
    float* KN = (float*)(p.ws + O_KN); bf16_t* QN = (bf16_t*)(p.ws + O_QN); bf16_t* VV = (bf16_t*)(p.ws + O_VV);
    float* BETA = (float*)(p.ws + O_BETA); float* GG = (float*)(p.ws + O_GG);
    const float* sm = (const float*)(p.ws + O_SMALL);
    const float* cw = sm + S_CONV;
    const int wid = TIDX >> 6, lane = TIDX & 63;
    for (int e = blockIdx.x * NTHR + TIDX; e < L_ * 64; e += gridDim.x * NTHR) {
        const int t = e >> 6, cidx = e & 63; const float v = ba[e];
        if (cidx < 32) BETA[t * 32 + cidx] = sigmf(v);
        else { const int h = cidx - 32; GG[t * 32 + h] = -expf(sm[S_ALOG + h]) * softplusf(v + sm[S_DTB + h]); }
    }
    for (int item = blockIdx.x * 8 + wid; item < 1024 * 64; item += gridDim.x * 8) {
        const int g = item & 63, tb = item >> 6, t0 = tb * 8;
        const int c = g * 128 + lane * 2;
        unsigned xr[11];
#pragma unroll
        for (int i = 0; i < 11; ++i) { const int tt = t0 - 3 + i; xr[i] = (tt >= 0) ? *(const unsigned*)(raw + (size_t)tt * 8192 + c) : 0u; }
        f32x2 w[4];
#pragma unroll
        for (int j = 0; j < 4; ++j) w[j] = *(const f32x2*)(cw + j * 8192 + c);
        float a0[8], a1[8];
#pragma unroll
        for (int i = 0; i < 8; ++i) { float s0 = 0.f, s1 = 0.f;
#pragma unroll
            for (int j = 0; j < 4; ++j) { s0 += w[j].x * bflo(xr[i + j]); s1 += w[j].y * bfhi(xr[i + j]); }
            a0[i] = silu_fast(s0); a1[i] = silu_fast(s1); }
        if (g < 32) {
            float ss[8];
#pragma unroll
            for (int i = 0; i < 8; ++i) ss[i] = a0[i] * a0[i] + a1[i] * a1[i];
#pragma unroll
            for (int d = 32; d >= 1; d >>= 1) {
#pragma unroll
                for (int i = 0; i < 8; ++i) ss[i] += __shfl_xor(ss[i], d); }
#pragma unroll
            for (int i = 0; i < 8; ++i) { const float r = 1.0f / sqrtf(ss[i] + 1e-6f); const int t = t0 + i;
                if (g < 16) { const float s = 0.08838834764831845f * r; *(unsigned*)(QN + (size_t)t * 2048 + g * 128 + lane * 2) = pk2(a0[i] * s, a1[i] * s); }
                else { f32x2 o; o.x = a0[i] * r; o.y = a1[i] * r; *(f32x2*)(KN + (size_t)t * 2048 + (g - 16) * 128 + lane * 2) = o; } }
        } else {
#pragma unroll
            for (int i = 0; i < 8; ++i) *(unsigned*)(VV + (size_t)(t0 + i) * 4096 + (g - 32) * 128 + lane * 2) = pk2(a0[i], a1[i]);
        }
    }
}

DI void phase_gdn_recurrent(const Params& p, unsigned char* lds) { const int TIDX = ltid();
    if (blockIdx.x < 16) {
        const float* KN = (const float*)(p.ws + O_KN); const bf16_t* QN = (const bf16_t*)(p.ws + O_QN); const bf16_t* VV = (const bf16_t*)(p.ws + O_VV);
        const float* BETA = (const float*)(p.ws + O_BETA); const float* GG = (const float*)(p.ws + O_GG);
        float* ORAW = (float*)(p.ws + O_QKVRAW);
        const int b = blockIdx.x, tid = TIDX, hl = tid >> 8, col = (tid >> 1) & 127, half = tid & 1, hv = 2 * b + hl;
        float* kb = (float*)lds;
        float* qb = kb + 16 * 128;
        float* vb = qb + 16 * 128;
        float* bb = vb + 16 * 256;
        float* gb = bb + 32;
        float S[64];
#pragma unroll
        for (int k = 0; k < 64; ++k) S[k] = 0.f;
        for (int t0 = 0; t0 < L_; t0 += 16) {
            __syncthreads();
#pragma unroll
            for (int i = 0; i < 4; ++i) { const int e = tid + i * 512, tt = e >> 7, r = e & 127;
                kb[e] = KN[(size_t)(t0 + tt) * 2048 + b * 128 + r]; qb[e] = bf2f(QN[(size_t)(t0 + tt) * 2048 + b * 128 + r]); }
#pragma unroll
            for (int i = 0; i < 8; ++i) { const int e = tid + i * 512, tt = e >> 8, r = e & 255; vb[e] = bf2f(VV[(size_t)(t0 + tt) * 4096 + 2 * b * 128 + r]); }
            if (tid < 32) { const int tt = tid >> 1, h = tid & 1; bb[tid] = BETA[(t0 + tt) * 32 + 2 * b + h]; gb[tid] = expf(GG[(t0 + tt) * 32 + 2 * b + h]); }
            __syncthreads();
            for (int tt = 0; tt < 16; ++tt) {
                const float* kk = kb + tt * 128 + half * 64; const float* qq = qb + tt * 128 + half * 64;
                const float eg = gb[tt * 2 + hl], be = bb[tt * 2 + hl], v = vb[tt * 256 + hl * 128 + col];
                float d0 = 0.f, d1 = 0.f, d2 = 0.f, d3 = 0.f;
#pragma unroll
                for (int k = 0; k < 64; k += 4) { if ((k & 15) == 0) asm volatile("" ::: "memory"); d0 += kk[k] * S[k]; d1 += kk[k + 1] * S[k + 1]; d2 += kk[k + 2] * S[k + 2]; d3 += kk[k + 3] * S[k + 3]; }
                float dd = (d0 + d1) + (d2 + d3); dd += __shfl_xor(dd, 1);
                const float vn = be * (v - eg * dd);
                float o0 = 0.f, o1 = 0.f, o2 = 0.f, o3 = 0.f;
#pragma unroll
                for (int k = 0; k < 64; k += 4) {
                    if ((k & 15) == 0) asm volatile("" ::: "memory");
                    S[k] = eg * S[k] + kk[k] * vn; o0 += qq[k] * S[k];
                    S[k + 1] = eg * S[k + 1] + kk[k + 1] * vn; o1 += qq[k + 1] * S[k + 1];
                    S[k + 2] = eg * S[k + 2] + kk[k + 2] * vn; o2 += qq[k + 2] * S[k + 2];
                    S[k + 3] = eg * S[k + 3] + kk[k + 3] * vn; o3 += qq[k + 3] * S[k + 3]; }
                float oo = (o0 + o1) + (o2 + o3); oo += __shfl_xor(oo, 1);
                if (half == 0) ORAW[(size_t)(t0 + tt) * 4096 + hv * 128 + col] = oo;
            }
        }
    }
    __syncthreads();
}
typedef float f32x16 __attribute__((ext_vector_type(16)));
DI int permpos(int a) { return ((a & 15) >> 2) * 8 + (a >> 4) * 4 + (a & 3); }
DI bf16_t bf1(float x) { return (bf16_t)(pk2(x, 0.f) & 0xffffu); }
DI void phase_gdn_prep(const Params& p, unsigned char* lds) { const int TIDX = ltid();
    const int tid = TIDX, wid = tid >> 6, lane = tid & 63;
    const bf16_t* raw = (const bf16_t*)(p.ws + O_QKVRAW); const float* ba = (const float*)(p.ws + O_BA);
    const float* sm = (const float*)(p.ws + O_SMALL); const float* cw = sm + S_CONV;
    float* Ks = (float*)lds;
    float* Qs = Ks + 64 * 132;
    float* KKs = Qs + 64 * 132;
    float* QKs = KKs + 64 * 65;
    float* gcs = QKs + 64 * 65;
    float* bts = gcs + 128;
    float* egs = bts + 128;
    bf16_t* Vs = (bf16_t*)(egs + 128);
    float* Am = Qs;
    for (int unit = blockIdx.x; unit < 2048; unit += gridDim.x) {
        const int hk = unit >> 7, n = unit & 127, t0 = n * 64;
        unsigned char* ohk = p.ws + O_PA_HK + (size_t)unit * 32768;
        __syncthreads();
        {
            unsigned xr[4][11]; f32x2 w[4][4];
#pragma unroll
            for (int itc = 0; itc < 4; ++itc) {
                const int cbase = (itc == 0) ? hk * 128 : (itc == 1) ? 2048 + hk * 128 : 4096 + (2 * hk + (itc - 2)) * 128;
                const int c = cbase + lane * 2, tb0 = t0 + wid * 8;
#pragma unroll
                for (int i = 0; i < 11; ++i) { const int tt = tb0 - 3 + i; xr[itc][i] = (tt >= 0) ? *(const unsigned*)(raw + (size_t)tt * 8192 + c) : 0u; }
#pragma unroll
                for (int j = 0; j < 4; ++j) w[itc][j] = *(const f32x2*)(cw + j * 8192 + c);
            }
#pragma unroll
            for (int itc = 0; itc < 4; ++itc) {
                float a0[8], a1[8];
#pragma unroll
                for (int i = 0; i < 8; ++i) { float s0 = 0.f, s1 = 0.f;
#pragma unroll
                    for (int j = 0; j < 4; ++j) { s0 += w[itc][j].x * bflo(xr[itc][i + j]); s1 += w[itc][j].y * bfhi(xr[itc][i + j]); }
                    a0[i] = silu_fast(s0); a1[i] = silu_fast(s1); }
                if (itc < 2) {
                    float ss[8];
#pragma unroll
                    for (int i = 0; i < 8; ++i) ss[i] = a0[i] * a0[i] + a1[i] * a1[i];
#pragma unroll
                    for (int d = 32; d >= 1; d >>= 1) {
#pragma unroll
                        for (int i = 0; i < 8; ++i) ss[i] += __shfl_xor(ss[i], d); }
                    float* dst = (itc == 0) ? Qs : Ks; const float sc = (itc == 0) ? 0.08838834764831845f : 1.0f;
#pragma unroll
                    for (int i = 0; i < 8; ++i) { const float r = sc / sqrtf(ss[i] + 1e-6f); f32x2 o; o.x = a0[i] * r; o.y = a1[i] * r; *(f32x2*)(dst + (wid * 8 + i) * 132 + lane * 2) = o; }
                } else {
#pragma unroll
                    for (int i = 0; i < 8; ++i) *(unsigned*)(Vs + (wid * 8 + i) * 256 + (itc - 2) * 128 + lane * 2) = pk2(a0[i], a1[i]);
                }
            }
        }
        if (wid < 2) { const int hv = 2 * hk + wid;
            const float av = ba[(size_t)(t0 + lane) * 64 + 32 + hv], bv = ba[(size_t)(t0 + lane) * 64 + hv];
            float s = -expf(sm[S_ALOG + hv]) * softplusf(av + sm[S_DTB + hv]);
#pragma unroll
            for (int d = 1; d < 64; d <<= 1) { const float o = __shfl_up(s, d); if (lane >= d) s += o; }
            gcs[wid * 64 + lane] = s; bts[wid * 64 + lane] = sigmf(bv); egs[wid * 64 + lane] = expf(s); }
        __syncthreads();
        {
            const float* X = (wid >> 2) ? Qs : Ks; const int ib = (wid >> 1) & 1, jb = wid & 1, r = lane & 31, h = lane >> 5;
            f32x16 acc;
#pragma unroll
            for (int i = 0; i < 16; ++i) acc[i] = 0.f;
            const float* ap = X + (ib * 32 + r) * 132; const float* bp = Ks + (jb * 32 + r) * 132;
#pragma unroll 8
            for (int u4 = 0; u4 < 32; ++u4) { const f32x4 a = *(const f32x4*)(ap + 4 * u4), b = *(const f32x4*)(bp + 4 * u4);
                acc = __builtin_amdgcn_mfma_f32_32x32x2f32(h ? a[1] : a[0], h ? b[1] : b[0], acc, 0, 0, 0);
                acc = __builtin_amdgcn_mfma_f32_32x32x2f32(h ? a[3] : a[2], h ? b[3] : b[2], acc, 0, 0, 0); }
            float* O = (wid >> 2) ? QKs : KKs;
#pragma unroll
            for (int i = 0; i < 16; ++i) O[(ib * 32 + (i & 3) + 8 * (i >> 2) + 4 * h) * 65 + jb * 32 + r] = acc[i];
        }
#pragma unroll 4
        for (int k = 0; k < 16; ++k) { const int idx = tid + 512 * k;
            { const int i = idx >> 7, dk = idx & 127, off = (dk & 96) + permpos(dk & 31);
              *(bf16_t*)(ohk + i * 256 + ((((off >> 3) ^ (i & 15))) << 4) + (off & 7) * 2) = bf1(Qs[i * 132 + dk]); }
            { const int dk = idx >> 6, tk = idx & 63, off = (tk & 32) + permpos(tk & 31);
              *(bf16_t*)(ohk + 16384 + dk * 128 + ((((off >> 3) ^ ((dk >> 1) & 7))) << 4) + (off & 7) * 2) = bf1(Ks[tk * 132 + dk]); } }
        __syncthreads();
#pragma unroll
        for (int r = 0; r < 2; ++r) { unsigned char* ohv = p.ws + O_PA_HV + (size_t)((2 * hk + r) * 128 + n) * 40960;
#pragma unroll 2
            for (int k = 0; k < 8; ++k) { const int idx = tid + 512 * k, i = idx >> 6, j = idx & 63;
                const float dec = __builtin_amdgcn_exp2f(1.4426950408889634f * (gcs[r * 64 + i] - gcs[r * 64 + j]));
                Am[r * 4096 + idx] = (j < i) ? bts[r * 64 + i] * KKs[i * 65 + j] * dec : 0.f;
                const float av = (j <= i) ? QKs[i * 65 + j] * dec : 0.f;
                const int off = (j & 32) + permpos(j & 31);
                *(bf16_t*)(ohv + 16384 + i * 128 + ((((off >> 3) ^ ((i >> 1) & 7))) << 4) + (off & 7) * 2) = bf1(av); } }
        if (tid < 128) { const int r = tid >> 6, i = tid & 63; float* G = (float*)(p.ws + O_PA_G) + (size_t)((2 * hk + r) * 128 + n) * 192;
            const float gi = gcs[r * 64 + i], gl = gcs[r * 64 + 63];
            G[i] = egs[r * 64 + i]; G[64 + i] = expf(gl - gi); if (i == 0) G[128] = expf(gl); }
        __syncthreads();
        {
            const int r = tid >> 8, c = tid & 255, hv = 2 * hk + r;
            unsigned char* ohv = p.ws + O_PA_HV + (size_t)(hv * 128 + n) * 40960;
            float sol[64];
            if (c < 128) {
#pragma unroll
                for (int i = 0; i < 64; ++i) sol[i] = bts[r * 64 + i] * bf2f(Vs[i * 256 + r * 128 + c]);
            } else {
#pragma unroll
                for (int i = 0; i < 64; ++i) sol[i] = bts[r * 64 + i] * egs[r * 64 + i] * Ks[i * 132 + (c - 128)];
            }
            __syncthreads();
            const float* ar = Am + r * 4096;
#pragma unroll
            for (int i = 1; i < 64; ++i) {
                float s0 = 0.f, s1 = 0.f, s2 = 0.f, s3 = 0.f;
#pragma unroll
                for (int j = 0; j < i; j += 4) { const f32x4 a = *(const f32x4*)(ar + i * 64 + j);
                    s0 += a[0] * sol[j]; s1 += a[1] * sol[j + 1]; s2 += a[2] * sol[j + 2]; s3 += a[3] * sol[j + 3]; }
                sol[i] -= (s0 + s1) + (s2 + s3);
            }
            if (c < 128) {
                bf16_t* U = (bf16_t*)(ohv + 24576); const int sl = c >> 4, l15 = c & 15;
#pragma unroll
                for (int mb = 0; mb < 4; ++mb)
#pragma unroll
                    for (int q = 0; q < 4; ++q) { const int i0 = mb * 16 + q * 4; u32x2 w; w.x = pk2(sol[i0], sol[i0 + 1]); w.y = pk2(sol[i0 + 2], sol[i0 + 3]);
                        *(u32x2*)(U + ((((sl * 4 + mb) * 4 + q) * 16 + l15) * 4)) = w; }
            } else {
                unsigned char* img = (unsigned char*)Ks + r * 16384;
                const int dk = c - 128, off = (dk & 96) + permpos(dk & 31), pc = off >> 3, eb = (off & 7) * 2;
#pragma unroll
                for (int i = 0; i < 64; ++i) *(bf16_t*)(img + i * 256 + ((pc ^ (i & 15)) << 4) + eb) = bf1(-sol[i]);
            }
        }
        __syncthreads();
#pragma unroll
        for (int k = 0; k < 4; ++k) { const int pi = tid + 512 * k, r = pi >> 10, pc = pi & 1023;
            *(u32x4*)(p.ws + O_PA_HV + (size_t)((2 * hk + r) * 128 + n) * 40960 + pc * 16) = *(const u32x4*)((const unsigned char*)Ks + r * 16384 + pc * 16); }
    }
    __syncthreads();
}

DI bf16x8 pack8(const f32x4& a, const f32x4& b) { u32x4 w; w.x = pk2(a[0], a[1]); w.y = pk2(a[2], a[3]); w.z = pk2(b[0], b[1]); w.w = pk2(b[2], b[3]); return __builtin_bit_cast(bf16x8, w); }
constexpr int SCAN_BUF = 66560;
DI void phase_gdn_scan(const Params& p, unsigned char* lds) { const int TIDX = ltid();
    const int tid = TIDX, wid = tid >> 6, lane = tid & 63, l15 = lane & 15, quad = lane >> 4;
    bf16_t* ORAW = (bf16_t*)(p.ws + O_ORAW);
    for (int item = blockIdx.x; item < 64; item += gridDim.x) {
        const int xcd_ = item & 7, slot_ = item >> 3, hk = xcd_ * 2 + (slot_ >> 2), hv = 2 * hk + ((slot_ >> 1) & 1), half = slot_ & 1;
        const unsigned char* hkb = p.ws + O_PA_HK + (size_t)(hk * 128) * 32768;
        const unsigned char* hvb = p.ws + O_PA_HV + (size_t)(hv * 128) * 40960;
        const unsigned char* gxb = p.ws + O_PA_G + (size_t)(hv * 128) * 768;
        __syncthreads();
        if (wid >= 4) {
            const int lt = tid - 256;
            u32x4 R0[17], R1[17];
#define SC_LD1(dst, ptr) asm volatile("global_load_dwordx4 %0, %1, off" : "=v"(dst) : "v"(ptr) : "memory")
#define SC_ST1(ptr, val) asm volatile("global_store_dwordx4 %0, %1, off\n\ts_nop 2" :: "v"(ptr), "v"(val) : "memory")
#define SC_LOAD(R, n_) do { const unsigned char* a_ = hvb + (size_t)(n_) * 40960 + lt * 16; const unsigned char* b_ = hkb + (size_t)(n_) * 32768 + lt * 16; \
                _Pragma("unroll") for (int k = 0; k < 4; ++k) SC_LD1(R[k], a_ + 4096 * k); \
                _Pragma("unroll") for (int k = 0; k < 4; ++k) SC_LD1(R[4 + k], b_ + 4096 * k); \
                _Pragma("unroll") for (int k = 0; k < 2; ++k) SC_LD1(R[8 + k], a_ + 16384 + 4096 * k); \
                _Pragma("unroll") for (int k = 0; k < 4; ++k) SC_LD1(R[10 + k], b_ + 16384 + 4096 * k); \
                _Pragma("unroll") for (int k = 0; k < 2; ++k) SC_LD1(R[14 + k], a_ + 24576 + half * 8192 + 4096 * k); \
                { const unsigned char* g_ = gxb + (size_t)(n_) * 768 + (lt < 48 ? lt : 47) * 16; SC_LD1(R[16], g_); } } while (0)
#define SC_WAIT(R, N) asm volatile("s_waitcnt vmcnt(" #N ")" : "+v"(R[0]), "+v"(R[1]), "+v"(R[2]), "+v"(R[3]), "+v"(R[4]), "+v"(R[5]), "+v"(R[6]), "+v"(R[7]), "+v"(R[8]), \
                "+v"(R[9]), "+v"(R[10]), "+v"(R[11]), "+v"(R[12]), "+v"(R[13]), "+v"(R[14]), "+v"(R[15]), "+v"(R[16]) :: "memory")
#define SC_WRITE(R, b_) do { unsigned char* d_ = lds + (b_) * SCAN_BUF; \
                _Pragma("unroll") for (int k = 0; k < 16; ++k) *(u32x4*)(d_ + (lt + 256 * k) * 16) = R[k]; \
                *(u32x4*)(d_ + 65536 + (lt < 48 ? lt : 47) * 16) = R[16]; } while (0)
#define SC_BAR_L() do { asm volatile("s_waitcnt lgkmcnt(0)" ::: "memory"); __builtin_amdgcn_s_barrier(); asm volatile("" ::: "memory"); } while (0)
#define SC_FLUSH(n_) do { const unsigned char* s_ = lds + 2 * SCAN_BUF + ((n_) & 1) * 8192; \
                _Pragma("unroll") for (int k = 0; k < 2; ++k) { const int pi = lt + 256 * k; const u32x4 w_ = *(const u32x4*)(s_ + pi * 16); \
                    bf16_t* o_ = ORAW + (size_t)((n_) * 64 + (pi >> 3)) * 4096 + hv * 128 + half * 64 + (pi & 7) * 8; SC_ST1(o_, w_); } } while (0)
            SC_LOAD(R0, 0); SC_WAIT(R0, 0); SC_WRITE(R0, 0); SC_LOAD(R1, 1);
            SC_FLUSH(0);
            SC_LOAD(R0, 2);
            SC_BAR_L();
            for (int n = 0; n < 128; n += 2) {
                SC_FLUSH(n > 0 ? n - 1 : 0);
                SC_WAIT(R1, 17); SC_WRITE(R1, 1); SC_LOAD(R1, (n + 3 < 128 ? n + 3 : 127));
                SC_BAR_L();
                SC_FLUSH(n);
                SC_WAIT(R0, 17); SC_WRITE(R0, 0); SC_LOAD(R0, (n + 4 < 128 ? n + 4 : 127));
                SC_BAR_L();
            }
            SC_FLUSH(127);
            asm volatile("s_waitcnt vmcnt(0)" ::: "memory");
#undef SC_FLUSH
#undef SC_LOAD
#undef SC_WRITE
#undef SC_BAR_L
#undef SC_WAIT
#undef SC_LD1
#undef SC_ST1
        } else {
            const int sl = half * 4 + wid;
            f32x4 Sacc[8];
#pragma unroll
            for (int i = 0; i < 8; ++i) Sacc[i] = (f32x4){0.f, 0.f, 0.f, 0.f};
            const int arow = l15 * 256, brow = l15 * 128, sw2 = l15 >> 1;
            asm volatile("" ::: "memory"); __builtin_amdgcn_s_barrier(); asm volatile("" ::: "memory");
            for (int n = 0; n < 128; ++n) {
                const unsigned char* Bb = lds + (n & 1) * SCAN_BUF;
                const unsigned char* Wl = Bb + arow; const unsigned char* Ql = Bb + 16384 + arow;
                const unsigned char* Al = Bb + 32768 + brow; const unsigned char* Kl = Bb + 40960 + brow;
                const unsigned char* Ul = Bb + 57344 + wid * 2048; const float* Gl = (const float*)(Bb + 65536);
                bf16x8 wf[16], qfr[16];
#pragma unroll
                for (int s = 0; s < 4; ++s) { const int po = ((4 * s + quad) ^ l15) << 4;
#pragma unroll
                    for (int mb = 0; mb < 4; ++mb) { wf[s * 4 + mb] = *(const bf16x8*)(Wl + mb * 4096 + po); qfr[s * 4 + mb] = *(const bf16x8*)(Ql + mb * 4096 + po); } }
                f32x4 vn[4], oacc[4];
#pragma unroll
                for (int mb = 0; mb < 4; ++mb) { const u32x2 uw = *(const u32x2*)(Ul + (((mb * 4 + quad) * 16 + l15) * 8));
                    vn[mb][0] = bflo(uw.x); vn[mb][1] = bfhi(uw.x); vn[mb][2] = bflo(uw.y); vn[mb][3] = bfhi(uw.y);
                    oacc[mb] = (f32x4){0.f, 0.f, 0.f, 0.f}; }
                bf16x8 Sf[4];
#pragma unroll
                for (int s = 0; s < 4; ++s) Sf[s] = pack8(Sacc[2 * s], Sacc[2 * s + 1]);
                __builtin_amdgcn_sched_barrier(0);
#pragma unroll
                for (int s = 0; s < 4; ++s)
#pragma unroll
                    for (int mb = 0; mb < 4; ++mb) vn[mb] = mfma16(wf[s * 4 + mb], Sf[s], vn[mb]);
                __builtin_amdgcn_sched_barrier(0);
                bf16x8 af[8], kf[16];
                const int po0 = ((0 + quad) ^ sw2) << 4, po1 = ((4 + quad) ^ sw2) << 4;
#pragma unroll
                for (int mb = 0; mb < 4; ++mb) { af[mb] = *(const bf16x8*)(Al + mb * 2048 + po0); af[4 + mb] = *(const bf16x8*)(Al + mb * 2048 + po1); }
                __builtin_amdgcn_sched_barrier(0);
#pragma unroll
                for (int s = 0; s < 4; ++s)
#pragma unroll
                    for (int mb = 0; mb < 4; ++mb) oacc[mb] = mfma16(qfr[s * 4 + mb], Sf[s], oacc[mb]);
                __builtin_amdgcn_sched_barrier(0);
#pragma unroll
                for (int m8 = 0; m8 < 8; ++m8) { kf[m8] = *(const bf16x8*)(Kl + m8 * 2048 + po0); kf[8 + m8] = *(const bf16x8*)(Kl + m8 * 2048 + po1); }
                f32x4 egv[4], eglv[4];
#pragma unroll
                for (int mb = 0; mb < 4; ++mb) { egv[mb] = *(const f32x4*)(Gl + mb * 16 + quad * 4); eglv[mb] = *(const f32x4*)(Gl + 64 + mb * 16 + quad * 4); }
                const float egl = Gl[128];
                bf16x8 vf[2];
#pragma unroll
                for (int s2 = 0; s2 < 2; ++s2) vf[s2] = pack8(vn[2 * s2], vn[2 * s2 + 1]);
#pragma unroll
                for (int mb = 0; mb < 4; ++mb) oacc[mb] *= egv[mb];
                __builtin_amdgcn_sched_barrier(0);
#pragma unroll
                for (int s2 = 0; s2 < 2; ++s2)
#pragma unroll
                    for (int mb = 0; mb < 4; ++mb) oacc[mb] = mfma16(af[s2 * 4 + mb], vf[s2], oacc[mb]);
#pragma unroll
                for (int mb = 0; mb < 4; ++mb) vn[mb] *= eglv[mb];
#pragma unroll
                for (int s2 = 0; s2 < 2; ++s2) vf[s2] = pack8(vn[2 * s2], vn[2 * s2 + 1]);
#pragma unroll
                for (int i = 0; i < 8; ++i) Sacc[i] *= egl;
                __builtin_amdgcn_sched_barrier(0);
#pragma unroll
                for (int s2 = 0; s2 < 2; ++s2)
#pragma unroll
                    for (int m8 = 0; m8 < 8; ++m8) Sacc[m8] = mfma16(kf[s2 * 8 + m8], vf[s2], Sacc[m8]);
                {   bf16_t* op = (bf16_t*)(lds + 2 * SCAN_BUF + (n & 1) * 8192) + (quad * 4) * 64 + wid * 16 + l15;
#pragma unroll
                    for (int mb = 0; mb < 4; ++mb) { const unsigned w01 = pk2(oacc[mb][0], oacc[mb][1]), w23 = pk2(oacc[mb][2], oacc[mb][3]);
                        op[(mb * 16 + 0) * 64] = (bf16_t)(w01 & 0xffffu); op[(mb * 16 + 1) * 64] = (bf16_t)(w01 >> 16);
                        op[(mb * 16 + 2) * 64] = (bf16_t)(w23 & 0xffffu); op[(mb * 16 + 3) * 64] = (bf16_t)(w23 >> 16); } }
                asm volatile("s_waitcnt lgkmcnt(0)" ::: "memory"); __builtin_amdgcn_s_barrier(); asm volatile("" ::: "memory");
            }
        }
    }
    __syncthreads();
}

DI void phase_gdn_gate(const Params& p) { const int TIDX = ltid();
    const bf16_t* ORAW = (const bf16_t*)(p.ws + O_ORAW); const bf16_t* Z = (const bf16_t*)(p.ws + O_Z); bf16_t* OG = (bf16_t*)(p.ws + O_OG);
    const int wid = TIDX >> 6, lane = TIDX & 63;
    const f32x2 nw = *(const f32x2*)((const float*)(p.ws + O_SMALL) + S_GNORM + lane * 2);
    for (int it4 = blockIdx.x * 8 + wid; it4 < L_ * 32 / 8; it4 += gridDim.x * 8) {
        unsigned ow[8]; unsigned zw[8]; float ss[8];
#pragma unroll
        for (int i = 0; i < 8; ++i) { const size_t off = (size_t)(it4 * 8 + i) * 128 + lane * 2; ow[i] = *(const unsigned*)(ORAW + off); zw[i] = *(const unsigned*)(Z + off); }
#pragma unroll
        for (int i = 0; i < 8; ++i) ss[i] = bflo(ow[i]) * bflo(ow[i]) + bfhi(ow[i]) * bfhi(ow[i]);
#pragma unroll
        for (int d = 32; d >= 1; d >>= 1) {
#pragma unroll
            for (int i = 0; i < 8; ++i) ss[i] += __shfl_xor(ss[i], d); }
#pragma unroll
        for (int i = 0; i < 8; ++i) { const size_t off = (size_t)(it4 * 8 + i) * 128 + lane * 2;
            const float rstd = 1.0f / sqrtf(ss[i] * (1.0f / 128.0f) + 1e-6f);
            *(unsigned*)(OG + off) = pk2(bflo(ow[i]) * rstd * nw.x * silu_fast(bflo(zw[i])), bfhi(ow[i]) * rstd * nw.y * silu_fast(bfhi(zw[i]))); }
    }
}

DI void phase_kvpost(const Params& p) { const int TIDX = ltid();
    const float* kv = (const float*)(p.ws + O_KVRAW);
    bf16_t* KB = (bf16_t*)(p.ws + O_KB); bf16_t* VB = (bf16_t*)(p.ws + O_VB); float* FC = (float*)(p.ws + O_FCUM);
    const int wid = TIDX >> 6, lane = TIDX & 63;
    const int gw = blockIdx.x * 8 + wid, nw = gridDim.x * 8;
    if (gw < 16) {
        const int h = gw; const float fb = ((const float*)(p.ws + O_SMALL))[S_FB + h];
        double carry = 0.0;
        for (int t0 = 0; t0 < L_; t0 += 64) {
            const float xl = kv[(size_t)(t0 + lane) * 1280 + 1024 + h] + fb;
            double s = (double)(-softplusf(-xl));
#pragma unroll
            for (int d = 1; d < 64; d <<= 1) { const double o = __shfl_up(s, d); if (lane >= d) s += o; }
            FC[(size_t)(t0 + lane) * 16 + h] = (float)(carry + s);
            carry += __shfl(s, 63);
        }
    }
    for (int t = gw; t < L_; t += nw) {
        const float* r = kv + (size_t)t * 1280;
#pragma unroll
        for (int hd = 0; hd < 2; ++hd) {
            const f32x4 k = *(const f32x4*)(r + hd * 256 + lane * 4);
            const float ss = wave_sum(k[0] * k[0] + k[1] * k[1] + k[2] * k[2] + k[3] * k[3]);
            const float rstd = 1.0f / sqrtf(ss * (1.0f / 256.0f) + 1e-6f);
            const f32x4 w = *(const f32x4*)((const float*)(p.ws + O_SMALL) + S_KNORM + lane * 4);
            u32x2 o; o.x = pk2(k[0] * rstd * w[0], k[1] * rstd * w[1]); o.y = pk2(k[2] * rstd * w[2], k[3] * rstd * w[3]);
            *(u32x2*)(KB + (size_t)t * 512 + hd * 256 + lane * 4) = o;
            const f32x4 v = *(const f32x4*)(r + 512 + hd * 256 + lane * 4);
            u32x2 ov; ov.x = pk2(v[0], v[1]); ov.y = pk2(v[2], v[3]);
            *(u32x2*)(VB + (size_t)t * 512 + hd * 256 + lane * 4) = ov;
        }
    }
}

DI void phase_attn_naive(const Params& p, unsigned char* lds) { const int TIDX = ltid();
    const bf16_t* QRAW = (const bf16_t*)(p.ws + O_QRAW); const bf16_t* GS = (const bf16_t*)(p.ws + O_GSIG);
    const bf16_t* KB = (const bf16_t*)(p.ws + O_KB); const bf16_t* VB = (const bf16_t*)(p.ws + O_VB); const float* FC = (const float*)(p.ws + O_FCUM);
    bf16_t* OG = (bf16_t*)(p.ws + O_OG2);
    const int wid = TIDX >> 6, lane = TIDX & 63;
    float* qs = (float*)lds + wid * 256;
    for (int item = blockIdx.x * 8 + wid; item < L_ * 16; item += gridDim.x * 8) {
        const int t = L_ - 1 - (item >> 4), h = item & 15, kvh = h >> 3;
        const u32x2 qw = *(const u32x2*)(QRAW + (size_t)t * 4096 + h * 256 + lane * 4);
        float q0 = bflo(qw.x), q1 = bfhi(qw.x), q2 = bflo(qw.y), q3 = bfhi(qw.y);
        const float ss = wave_sum(q0 * q0 + q1 * q1 + q2 * q2 + q3 * q3);
        const float rs = (1.0f / sqrtf(ss * (1.0f / 256.0f) + 1e-6f)) * 0.0625f;
        const f32x4 qn = *(const f32x4*)((const float*)(p.ws + O_SMALL) + S_QNORM + lane * 4);
        __builtin_amdgcn_wave_barrier();
        f32x4 qv; qv[0] = q0 * rs * qn[0]; qv[1] = q1 * rs * qn[1]; qv[2] = q2 * rs * qn[2]; qv[3] = q3 * rs * qn[3];
        *(f32x4*)(qs + lane * 4) = qv;
        __builtin_amdgcn_wave_barrier();
        const float Ft = FC[(size_t)t * 16 + h];
        float m = -INFINITY, l = 0.f, O0 = 0.f, O1 = 0.f, O2 = 0.f, O3 = 0.f;
        for (int s0 = 0; s0 <= t; s0 += 64) {
            const int s = s0 + lane; const bool valid = s <= t;
            float dot = 0.f;
            if (valid) {
                const u32x4* kr = (const u32x4*)(KB + ((size_t)s * 2 + kvh) * 256);
#pragma unroll 4
                for (int c = 0; c < 32; ++c) { const u32x4 kw = kr[c]; const f32x4 qa = *(const f32x4*)(qs + c * 8), qb = *(const f32x4*)(qs + c * 8 + 4);
                    dot += qa[0] * bflo(kw.x) + qa[1] * bfhi(kw.x) + qa[2] * bflo(kw.y) + qa[3] * bfhi(kw.y)
                         + qb[0] * bflo(kw.z) + qb[1] * bfhi(kw.z) + qb[2] * bflo(kw.w) + qb[3] * bfhi(kw.w); }
            }
            const float sc = valid ? dot + (Ft - FC[(size_t)s * 16 + h]) : -INFINITY;
            const float mn = fmaxf(m, wave_max(sc));
            const float alpha = expf(m - mn);
            const float pr = valid ? expf(sc - mn) : 0.f;
            l = l * alpha + wave_sum(pr);
            O0 *= alpha; O1 *= alpha; O2 *= alpha; O3 *= alpha;
            const int nk = min(64, t - s0 + 1);
            for (int j = 0; j < nk; ++j) {
                const float pj = __shfl(pr, j);
                const u32x2 vw = *(const u32x2*)(VB + ((size_t)(s0 + j) * 2 + kvh) * 256 + lane * 4);
                O0 += pj * bflo(vw.x); O1 += pj * bfhi(vw.x); O2 += pj * bflo(vw.y); O3 += pj * bfhi(vw.y);
            }
            m = mn;
        }
        const float il = 1.0f / l;
        const u32x2 gw2 = *(const u32x2*)(GS + (size_t)t * 4096 + h * 256 + lane * 4);
        u32x2 o; o.x = pk2(O0 * il * bflo(gw2.x), O1 * il * bfhi(gw2.x)); o.y = pk2(O2 * il * bflo(gw2.y), O3 * il * bfhi(gw2.y));
        *(u32x2*)(OG + (size_t)t * 4096 + h * 256 + lane * 4) = o;
    }
    __syncthreads();
}

DI void phase_kvpost2(const Params& p, unsigned char* lds) { const int TIDX = ltid();
    const float* kv = (const float*)(p.ws + O_KVRAW); const float* sm = (const float*)(p.ws + O_SMALL);
    bf16_t* KB = (bf16_t*)(p.ws + O_KB); bf16_t* VT = (bf16_t*)(p.ws + O_VB); float* FCT = (float*)(p.ws + O_FCUM); bf16_t* Q = (bf16_t*)(p.ws + O_QRAW);
    const int wid = TIDX >> 6, lane = TIDX & 63;
    const int gw = blockIdx.x * 8 + wid, nw = gridDim.x * 8;
    for (int h = blockIdx.x; h < 16; h += gridDim.x) {
        double* wtot = (double*)lds;
        const float fb = sm[S_FB + h];
        float xs[16];
#pragma unroll
        for (int it = 0; it < 16; ++it) xs[it] = kv[(size_t)(wid * 1024 + it * 64 + lane) * 1280 + 1024 + h];
        double vals[16]; double run = 0.0;
#pragma unroll
        for (int it = 0; it < 16; ++it) {
            double s = (double)(-softplusf(-(xs[it] + fb)));
#pragma unroll
            for (int d = 1; d < 64; d <<= 1) { const double o = __shfl_up(s, d); if (lane >= d) s += o; }
            vals[it] = run + s; run += __shfl(s, 63);
        }
        __syncthreads();
        if (lane == 0) wtot[wid] = run;
        __syncthreads();
        double off = 0.0;
#pragma unroll
        for (int w = 0; w < 8; ++w) off += (w < wid) ? wtot[w] : 0.0;
#pragma unroll
        for (int it = 0; it < 16; ++it) FCT[(size_t)h * L_ + wid * 1024 + it * 64 + lane] = (float)((off + vals[it]) * 1.4426950408889634);
        __syncthreads();
    }
    {
        const f32x4 qn = *(const f32x4*)(sm + S_QNORM + lane * 4);
        for (int it8 = gw; it8 < L_ * 16 / 8; it8 += nw) {
            u32x2 qw[8]; float ss[8];
#pragma unroll
            for (int i = 0; i < 8; ++i) qw[i] = *(const u32x2*)(Q + (size_t)(it8 * 8 + i) * 256 + lane * 4);
#pragma unroll
            for (int i = 0; i < 8; ++i) { const float q0 = bflo(qw[i].x), q1 = bfhi(qw[i].x), q2 = bflo(qw[i].y), q3 = bfhi(qw[i].y); ss[i] = q0 * q0 + q1 * q1 + q2 * q2 + q3 * q3; }
#pragma unroll
            for (int d = 32; d >= 1; d >>= 1) {
#pragma unroll
                for (int i = 0; i < 8; ++i) ss[i] += __shfl_xor(ss[i], d); }
#pragma unroll
            for (int i = 0; i < 8; ++i) { const float rs = (1.0f / sqrtf(ss[i] * (1.0f / 256.0f) + 1e-6f)) * (0.0625f * 1.4426950408889634f);
                u32x2 o; o.x = pk2(bflo(qw[i].x) * rs * qn[0], bfhi(qw[i].x) * rs * qn[1]); o.y = pk2(bflo(qw[i].y) * rs * qn[2], bfhi(qw[i].y) * rs * qn[3]);
                *(u32x2*)(Q + (size_t)(it8 * 8 + i) * 256 + lane * 4) = o; }
        }
    }
    bf16_t* vt = (bf16_t*)lds;
    const f32x4 kw = *(const f32x4*)(sm + S_KNORM + lane * 4);
    for (int blk = blockIdx.x; blk < 128; blk += gridDim.x) {
        __syncthreads();
        for (int rr = wid; rr < 64; rr += 8) {
            const int t = blk * 64 + rr;
            const float* r = kv + (size_t)t * 1280;
#pragma unroll
            for (int hd = 0; hd < 2; ++hd) {
                const f32x4 k = *(const f32x4*)(r + hd * 256 + lane * 4);
                const float ss = wave_sum(k[0] * k[0] + k[1] * k[1] + k[2] * k[2] + k[3] * k[3]);
                const float rstd = 1.0f / sqrtf(ss * (1.0f / 256.0f) + 1e-6f);
                u32x2 o; o.x = pk2(k[0] * rstd * kw[0], k[1] * rstd * kw[1]); o.y = pk2(k[2] * rstd * kw[2], k[3] * rstd * kw[3]);
                *(u32x2*)(KB + (size_t)t * 512 + hd * 256 + lane * 4) = o;
                const f32x4 v = *(const f32x4*)(r + 512 + hd * 256 + lane * 4);
                const unsigned v01 = pk2(v[0], v[1]), v23 = pk2(v[2], v[3]);
                bf16_t* vp = vt + (hd * 256 + lane * 4) * 72 + ((rr & 32) + permpos(rr & 31));
                vp[0] = (bf16_t)(v01 & 0xffffu); vp[72] = (bf16_t)(v01 >> 16); vp[144] = (bf16_t)(v23 & 0xffffu); vp[216] = (bf16_t)(v23 >> 16);
            }
        }
        __syncthreads();
#pragma unroll
        for (int i = 0; i < 8; ++i) { const int pi = TIDX + 512 * i, d = pi >> 3, c = pi & 7;
            const u32x4 w = *(const u32x4*)(vt + d * 72 + c * 8);
            *(u32x4*)(VT + (size_t)d * L_ + blk * 64 + c * 8) = w; }
    }
    __syncthreads();
}

DI void phase_attn(const Params& p, unsigned char* lds) { const int TIDX = ltid();
    const bf16_t* QN = (const bf16_t*)(p.ws + O_QRAW); const bf16_t* GS = (const bf16_t*)(p.ws + O_GSIG);
    const bf16_t* KB = (const bf16_t*)(p.ws + O_KB); const bf16_t* VT = (const bf16_t*)(p.ws + O_VB); const float* FCT = (const float*)(p.ws + O_FCUM);
    bf16_t* OG = (bf16_t*)(p.ws + O_OG2);
    const int tid = TIDX, wid = __builtin_amdgcn_readfirstlane(tid >> 6), lane = tid & 63, l15 = lane & 15, quad = lane >> 4;
    const float LOG2E = 1.4426950408889634f;
    float kmax;
    { const f32x4 kw = *(const f32x4*)((const float*)(p.ws + O_SMALL) + S_KNORM + lane * 4);
      kmax = wave_max(fmaxf(fmaxf(fabsf(kw[0]), fabsf(kw[1])), fmaxf(fabsf(kw[2]), fabsf(kw[3])))) * 16.0f * 1.01f; }
    unsigned kofs0, vofs0;
    { const int r = 2 * wid + (lane >> 5), c = (lane & 31) ^ (r & 15); kofs0 = (unsigned)((r * 512 + c * 8) * 2); }
    { const int r = 8 * wid + (lane >> 3), c = (lane & 7) ^ ((r >> 1) & 7); vofs0 = (unsigned)((r * L_ + c * 8) * 2); }
    for (int si = blockIdx.x; si < 256; si += gridDim.x) {
        const int xcd = si & 7, slot = si >> 3, kvh = xcd & 1, cidx = (xcd >> 1) * 32 + slot, h = kvh * 8 + (cidx & 7), jj = cidx >> 3;
        const bf16_t* Kg = KB + kvh * 256;
        const bf16_t* Vg = VT + (size_t)kvh * 256 * L_;
        const float* Fh = FCT + (size_t)h * L_;
        for (int it = 0; it < 4; ++it) {
            const int qb = (it == 0) ? 63 - jj : (it == 1) ? 32 + jj : (it == 2) ? 31 - jj : jj;
            const int q0 = qb * 128, ntile = 2 * qb + 2;
            const int qrow = q0 + wid * 16 + l15;
            bf16x8 qf[8];
#pragma unroll
            for (int s = 0; s < 8; ++s) qf[s] = *(const bf16x8*)(QN + (size_t)qrow * 4096 + h * 256 + s * 32 + quad * 8);
            float qss = 0.f;
#pragma unroll
            for (int s = 0; s < 8; ++s) { const u32x4 qw = __builtin_bit_cast(u32x4, qf[s]);
                qss += bflo(qw.x) * bflo(qw.x) + bfhi(qw.x) * bfhi(qw.x) + bflo(qw.y) * bflo(qw.y) + bfhi(qw.y) * bfhi(qw.y)
                     + bflo(qw.z) * bflo(qw.z) + bfhi(qw.z) * bfhi(qw.z) + bflo(qw.w) * bflo(qw.w) + bfhi(qw.w) * bfhi(qw.w); }
            qss += __shfl_xor(qss, 16); qss += __shfl_xor(qss, 32);
            const float Mrow = sqrtf(qss) * kmax;
            const float Ft = Fh[qrow] - Mrow;
            f32x4 oacc[16];
#pragma unroll
            for (int d = 0; d < 16; ++d) oacc[d] = (f32x4){0.f, 0.f, 0.f, 0.f};
            float lrun = 0.f;
#define ATT_DMA(kt_, b_) do { const char* kb_ = (const char*)Kg + (size_t)(kt_) * 65536; const char* vb_ = (const char*)Vg + (size_t)(kt_) * 128; \
                PG8_LAS unsigned char* L_ = (PG8_LAS unsigned char*)lds + (b_) * 65536 + wid * 1024; \
                _Pragma("unroll") for (int i = 0; i < 4; ++i) { \
                    __builtin_amdgcn_global_load_lds((const unsigned*)(kb_ + (size_t)i * 16384 + kofs0), (PG8_LAS unsigned*)(L_ + i * 8192), 16, 0, 0); \
                    __builtin_amdgcn_global_load_lds((const unsigned*)(vb_ + (size_t)i * 1048576 + vofs0), (PG8_LAS unsigned*)(L_ + 32768 + i * 8192), 16, 0, 0); } \
                if (wid == 0) __builtin_amdgcn_global_load_lds((const unsigned*)(Fh + 64 * (kt_) + lane), (PG8_LAS unsigned*)((PG8_LAS unsigned char*)lds + 131072 + (b_) * 256), 4, 0, 0); } while (0)
#define ATT_DMA1(kt_, b_, i_) do { const char* kb_ = (const char*)Kg + (size_t)(kt_) * 65536; const char* vb_ = (const char*)Vg + (size_t)(kt_) * 128; \
                PG8_LAS unsigned char* L_ = (PG8_LAS unsigned char*)lds + (b_) * 65536 + wid * 1024; \
                __builtin_amdgcn_global_load_lds((const unsigned*)(kb_ + (size_t)(i_) * 16384 + kofs0), (PG8_LAS unsigned*)(L_ + (i_) * 8192), 16, 0, 0); \
                __builtin_amdgcn_global_load_lds((const unsigned*)(vb_ + (size_t)(i_) * 1048576 + vofs0), (PG8_LAS unsigned*)(L_ + 32768 + (i_) * 8192), 16, 0, 0); \
                if ((i_) == 3 && wid == 0) __builtin_amdgcn_global_load_lds((const unsigned*)(Fh + 64 * (kt_) + lane), (PG8_LAS unsigned*)((PG8_LAS unsigned char*)lds + 131072 + (b_) * 256), 4, 0, 0); } while (0)
            ATT_DMA(0, 0);
            asm volatile("s_waitcnt vmcnt(0)" ::: "memory");
            __syncthreads();
            for (int kt = 0; kt < ntile; ++kt) {
                const int b = kt & 1;
                const bool more = (kt + 1 < ntile);
                const int wq0 = q0 + wid * 16;
                const bool compute = (64 * kt <= wq0 + 15);
                if (more && (!compute || wid < 4)) ATT_DMA(kt + 1, b ^ 1);
                if (compute) {
                    const unsigned char* Kb = lds + b * 65536; const unsigned char* Vb = Kb + 32768;
                    const float* Fl = (const float*)(lds + 131072 + b * 256);
                    f32x4 sacc[4];
#pragma unroll
                    for (int kb = 0; kb < 4; ++kb) { const f32x4 fs = *(const f32x4*)(Fl + kb * 16 + quad * 4); sacc[kb] = Ft - fs; }
                    const unsigned char* kp0 = Kb + l15 * 512;
                    bf16x8 kfA[4], kfB[4];
                    __builtin_amdgcn_s_setprio(1);
#pragma unroll
                    for (int kb = 0; kb < 4; ++kb) kfA[kb] = *(const bf16x8*)(kp0 + (((0 + quad) ^ l15) * 16) + kb * 8192);
#pragma unroll
                    for (int s = 0; s < 8; s += 2) {
#pragma unroll
                        for (int kb = 0; kb < 4; ++kb) kfB[kb] = *(const bf16x8*)(kp0 + (((4 * (s + 1) + quad) ^ l15) * 16) + kb * 8192);
#pragma unroll
                        for (int kb = 0; kb < 4; ++kb) sacc[kb] = mfma16(kfA[kb], qf[s], sacc[kb]);
                        asm volatile("" ::: "memory");
                        if (s + 2 < 8) {
#pragma unroll
                            for (int kb = 0; kb < 4; ++kb) kfA[kb] = *(const bf16x8*)(kp0 + (((4 * (s + 2) + quad) ^ l15) * 16) + kb * 8192); }
#pragma unroll
                        for (int kb = 0; kb < 4; ++kb) sacc[kb] = mfma16(kfB[kb], qf[s + 1], sacc[kb]);
                        asm volatile("" ::: "memory");
                    }
                    __builtin_amdgcn_s_setprio(0);
                    if (more && wid >= 4) ATT_DMA(kt + 1, b ^ 1);
                    const bool domask = (64 * kt + 63 > wq0);
                    float psum = 0.f;
#pragma unroll
                    for (int kb = 0; kb < 4; ++kb) {
                        const int key0 = 64 * kt + kb * 16 + quad * 4;
#pragma unroll
                        for (int j = 0; j < 4; ++j) { float v = sacc[kb][j];
                            if (domask && (key0 + j > qrow)) v = -INFINITY;
                            const float pv = __builtin_amdgcn_exp2f(v); psum += pv; sacc[kb][j] = pv; } }
                    lrun += psum;
                    const int sw = l15 >> 1;
                    __builtin_amdgcn_s_setprio(1);
#pragma unroll
                    for (int s2 = 0; s2 < 2; ++s2) {
                        const bf16x8 pf = pack8(sacc[2 * s2], sacc[2 * s2 + 1]);
                        const unsigned char* pv_ = Vb + l15 * 128 + (((4 * s2 + quad) ^ sw) * 16);
                        bf16x8 vA[4], vB[4];
#pragma unroll
                        for (int e = 0; e < 4; ++e) vA[e] = *(const bf16x8*)(pv_ + e * 2048);
#pragma unroll
                        for (int d8 = 0; d8 < 16; d8 += 8) {
#pragma unroll
                            for (int e = 0; e < 4; ++e) vB[e] = *(const bf16x8*)(pv_ + (d8 + 4 + e) * 2048);
#pragma unroll
                            for (int e = 0; e < 4; ++e) oacc[d8 + e] = mfma16(vA[e], pf, oacc[d8 + e]);
                            asm volatile("" ::: "memory");
                            if (d8 + 8 < 16) {
#pragma unroll
                                for (int e = 0; e < 4; ++e) vA[e] = *(const bf16x8*)(pv_ + (d8 + 8 + e) * 2048); }
#pragma unroll
                            for (int e = 0; e < 4; ++e) oacc[d8 + 4 + e] = mfma16(vB[e], pf, oacc[d8 + 4 + e]);
                            asm volatile("" ::: "memory");
                        }
                    }
                    __builtin_amdgcn_s_setprio(0);
                }
                asm volatile("s_waitcnt vmcnt(0)" ::: "memory");
                __syncthreads();
            }
#undef ATT_DMA
#undef ATT_DMA1
            float lt = lrun; lt += __shfl_xor(lt, 16); lt += __shfl_xor(lt, 32);
            const float il = 1.0f / lt;
#pragma unroll
            for (int d = 0; d < 16; ++d) {
                const size_t off = (size_t)qrow * 4096 + h * 256 + d * 16 + quad * 4;
                const u32x2 g = *(const u32x2*)(GS + off);
                u32x2 o; o.x = pk2(oacc[d][0] * il * bflo(g.x), oacc[d][1] * il * bfhi(g.x)); o.y = pk2(oacc[d][2] * il * bflo(g.y), oacc[d][3] * il * bfhi(g.y));
                *(u32x2*)(OG + off) = o; }
        }
    }
    __syncthreads();
}

constexpr int NPHASE = 21;
template <int PH>
DI void run_phase(const Params& p, unsigned char* lds) {
    unsigned char* ws = p.ws;
    const float* mod = (const float*)(ws + O_MOD);
    float* XS = (float*)(ws + O_XS);
    bf16_t* H = (bf16_t*)(ws + O_H); bf16_t* H2 = (bf16_t*)(ws + O_H2);
    const float* sm = (const float*)(ws + O_SMALL);
    if constexpr (PH == 0) { phase_copysmall(p); phase_adaln(p, lds, (int)blockIdx.x, (int)gridDim.x, 0, 24); phase_convert(p, lds, (int)blockIdx.x, (int)gridDim.x, 0, 2); }
    else if constexpr (PH == 1) { phase_modreduce(p, 0, 12288); }
    else if constexpr (PH == 2) { phase_normmod(p.x, sm + S_NORM_MIX, mod + 0, mod + 2048, H, nullptr, nullptr, nullptr, nullptr); }
    else if constexpr (PH == 3) { EpiGdnIn E{(bf16_t*)(ws + O_QKVRAW), (bf16_t*)(ws + O_Z), (float*)(ws + O_BA)}; run_gemm(lds, H, (const bf16_t*)(ws + O_WGIN), 12544, 2048, E); }
    else if constexpr (PH == 4) {   }
    else if constexpr (PH == 5) { phase_gdn_prep(p, lds); }
    else if constexpr (PH == 6) {
        if (blockIdx.x < 64 || gridDim.x <= 64) phase_gdn_scan(p, lds);
        if (gridDim.x <= 64) { phase_adaln(p, lds, (int)blockIdx.x, (int)gridDim.x, 24, 40); phase_convert(p, lds, (int)blockIdx.x, (int)gridDim.x, 2, 9); }
        else if (blockIdx.x >= 64) { phase_adaln(p, lds, (int)blockIdx.x - 64, (int)gridDim.x - 64, 24, 40); phase_convert(p, lds, (int)blockIdx.x - 64, (int)gridDim.x - 64, 2, 9); }
    }
    else if constexpr (PH == 7) { phase_gdn_gate(p); phase_modreduce(p, 12288, 32768); }
    else if constexpr (PH == 8) { EpiResid E{p.x, XS, mod + 2 * 2048}; run_gemm(lds, (const bf16_t*)(ws + O_OG), (const bf16_t*)(ws + O_WGOUT), 2048, 4096, E); }
    else if constexpr (PH == 9) { phase_normmod(XS, sm + S_NORM_FFN, mod + 3 * 2048, mod + 4 * 2048, H, nullptr, nullptr, nullptr, nullptr); }
    else if constexpr (PH == 10) { EpiSwiglu E{(bf16_t*)(ws + O_HID)}; run_gemm(lds, H, (const bf16_t*)(ws + O_WFIN), 11264, 2048, E); }
    else if constexpr (PH == 11) { EpiResid E{XS, XS, mod + 5 * 2048}; run_gemm(lds, (const bf16_t*)(ws + O_HID), (const bf16_t*)(ws + O_WFOUT), 2048, 5632, E); }
    else if constexpr (PH == 12) { phase_normmod(XS, sm + S_NORM_MIX + 2048, mod + 12288, mod + 12288 + 2048, H, sm + S_KVNORM, mod + 24576, mod + 24576 + 2048, H2); }
    else if constexpr (PH == 13) {
        { EpiFoxIn E{(bf16_t*)(ws + O_QRAW), (bf16_t*)(ws + O_GSIG)}; run_gemm(lds, H, (const bf16_t*)(ws + O_WXIN), 8192, 2048, E); }
        { EpiKV E{(float*)(ws + O_KVRAW)}; run_gemm(lds, H2, (const bf16_t*)(ws + O_WKV), 1280, 2048, E); }
    }
    else if constexpr (PH == 14) { phase_kvpost2(p, lds); }
    else if constexpr (PH == 15) { phase_attn(p, lds); }
    else if constexpr (PH == 16) { EpiResid E{XS, XS, mod + 12288 + 2 * 2048}; run_gemm(lds, (const bf16_t*)(ws + O_OG2), (const bf16_t*)(ws + O_WXOUT), 2048, 4096, E); }
    else if constexpr (PH == 17) { phase_normmod(XS, sm + S_NORM_FFN + 2048, mod + 12288 + 3 * 2048, mod + 12288 + 4 * 2048, H, nullptr, nullptr, nullptr, nullptr); }
    else if constexpr (PH == 18) { EpiSwiglu E{(bf16_t*)(ws + O_HID)}; run_gemm(lds, H, (const bf16_t*)(ws + O_WFIN + SZ_WFIN), 11264, 2048, E); }
    else if constexpr (PH == 19) { EpiResid E{XS, XS, mod + 12288 + 5 * 2048}; run_gemm(lds, (const bf16_t*)(ws + O_HID), (const bf16_t*)(ws + O_WFOUT + SZ_WFOUT), 2048, 5632, E); }
    else if constexpr (PH == 20) { phase_final(XS, sm + S_ONORM, mod + 28672, mod + 28672 + 2048, p.out); }
}

#ifndef MEGA
#define MEGA 1
#endif

#if MEGA
#ifndef EXTRASYNC
#define EXTRASYNC 0
#endif
#ifndef REPMASK
#define REPMASK 0
#endif
#ifndef PHMASK
#define PHMASK 0x1FFFFF
#endif
#define LAS __attribute__((address_space(3)))
#define XB_TMO      128
#define XB_XCNT(j)  (256  + 64 * (j))
#define XB_XSUB(j)  (1280 + 64 * (j))
#define XB_XGEN(j)  (2304 + 64 * (j))
#define XB_TOP      3328
#define XB_TOPGEN   3392
#define XCD_BAR_WORDS 3456
#define XB_SPIN_CAP (1u << 18)

__device__ __forceinline__ unsigned xb_ld(unsigned* p)              { return __hip_atomic_load(p, __ATOMIC_RELAXED, __HIP_MEMORY_SCOPE_AGENT); }
__device__ __forceinline__ unsigned xb_add(unsigned* p, unsigned v) { return __hip_atomic_fetch_add(p, v, __ATOMIC_RELAXED, __HIP_MEMORY_SCOPE_AGENT); }
__device__ __forceinline__ unsigned xb_xcc_id() { return (unsigned)__builtin_amdgcn_s_getreg((3 << 11) | 20) & 0xFu; }
#define XB_SPIN(cond, bar) do { unsigned _sp = 0; while (cond) { __builtin_amdgcn_s_sleep(1); \
    if ((++_sp & 255u) == 0u) { if (xb_ld(&(bar)[XB_TMO])) break; if (_sp > XB_SPIN_CAP) { atomicAdd(&(bar)[XB_TMO], 1u); break; } } } } while (0)

struct XcdBarrier {
    unsigned* bar; unsigned x;
    volatile LAS unsigned* st;
};

__device__ __forceinline__ XcdBarrier xcd_barrier_post(unsigned* bar, volatile LAS unsigned* st) {
    XcdBarrier b; b.bar = bar; b.x = xb_xcc_id(); b.st = st;
    if (threadIdx.x == 0) (void)xb_add(&bar[XB_XCNT(b.x)], 1u);
    return b;
}
__device__ __forceinline__ void xcd_barrier_complete(unsigned* bar, unsigned x, unsigned& nloc, unsigned& nx) {
    const unsigned G = gridDim.x * gridDim.y * gridDim.z;
    unsigned sum, cnt, mine, sp = 0u;
    for (;;) {
        sum = 0u; cnt = 0u; mine = 0u;
#pragma unroll
        for (unsigned j = 0; j < 16; ++j) { const unsigned c = xb_ld(&bar[XB_XCNT(j)]); sum += c; cnt += (c > 0u) ? 1u : 0u; mine = (j == x) ? c : mine; }
        if (sum == G) break;
        __builtin_amdgcn_s_sleep(1);
        if ((++sp & 255u) == 0u) { if (xb_ld(&bar[XB_TMO])) break; if (sp > XB_SPIN_CAP) { atomicAdd(&bar[XB_TMO], 1u); break; } }
    }
    nloc = mine > 0u ? mine : 1u; nx = cnt > 0u ? cnt : 1u;
}

__device__ __forceinline__ void xcd_barrier(const XcdBarrier& b) {
    asm volatile("s_waitcnt vmcnt(0)" ::: "memory");
    __syncthreads();
    if (threadIdx.x == 0) {
        unsigned* bar = b.bar;
        __builtin_amdgcn_s_waitcnt(0);
        unsigned nloc = b.st[0], nx = b.st[1];
        if (nloc == 0u) { xcd_barrier_complete(bar, b.x, nloc, nx); b.st[0] = nloc; b.st[1] = nx; }
        const unsigned old = xb_add(&bar[XB_XSUB(b.x)], 1u);
        const unsigned gen = old / nloc;
        if (old + 1u == (gen + 1u) * nloc) {
            __builtin_amdgcn_fence(__ATOMIC_RELEASE, "agent");
            asm volatile("s_waitcnt vmcnt(0)" ::: "memory");
            const unsigned og = xb_add(&bar[XB_TOP], 1u);
            const unsigned tg = og / nx;
            if (og + 1u == (tg + 1u) * nx) xb_add(&bar[XB_TOPGEN], 1u);
            else XB_SPIN(xb_ld(&bar[XB_TOPGEN]) == tg, bar);
            __builtin_amdgcn_fence(__ATOMIC_ACQUIRE, "agent");
            xb_add(&bar[XB_XGEN(b.x)], 1u);
            asm volatile("s_waitcnt vmcnt(0)" ::: "memory");
        } else {
            XB_SPIN(xb_ld(&bar[XB_XGEN(b.x)]) == gen, bar);
            __builtin_amdgcn_fence(__ATOMIC_ACQUIRE, "agent");
            asm volatile("s_waitcnt vmcnt(0)" ::: "memory");
        }
    }
    __syncthreads();
}

template <int PH>
DI void run_all(const Params& p, unsigned char* lds, cg::grid_group& grid, const XcdBarrier& xb) {
    if constexpr ((PHMASK >> PH) & 1) run_phase<PH>(p, lds);
    if constexpr ((REPMASK >> PH) & 1) { xcd_barrier(xb); run_phase<PH>(p, lds); }
    if constexpr (PH + 1 < NPHASE) {
        if constexpr (PH != 4) xcd_barrier(xb);
        run_all<PH + 1>(p, lds, grid, xb);
    }
}
__global__ void __launch_bounds__(NTHR) mega_kernel(Params p) {
    extern __shared__ __attribute__((aligned(16))) unsigned char lds[];
    cg::grid_group grid = cg::this_grid();
    volatile LAS unsigned* st = (volatile LAS unsigned*)((LAS unsigned char*)lds + 155648);
    if (threadIdx.x < 2) st[threadIdx.x] = 0u;
    __syncthreads();
    const XcdBarrier xb = xcd_barrier_post((unsigned*)(p.ws + O_BARCTR), st);
    if (p.out == nullptr) grid.sync();
    run_all<0>(p, lds, grid, xb);
}
#else
template <int PH>
__global__ void __launch_bounds__(NTHR) phase_kernel(Params p) {
    extern __shared__ __attribute__((aligned(16))) unsigned char lds[];
    run_phase<PH>(p, lds);
}
template <int PH>
static void launch_phases(const Params& p, int grid, hipStream_t stream, bool setattr) {
    if (setattr) (void)hipFuncSetAttribute((const void*)phase_kernel<PH>, hipFuncAttributeMaxDynamicSharedMemorySize, LDS_BYTES);
    else hipLaunchKernelGGL(phase_kernel<PH>, dim3(grid), dim3(NTHR), LDS_BYTES, stream, p);
    if constexpr (PH + 1 < NPHASE) launch_phases<PH + 1>(p, grid, stream, setattr);
}
#endif

extern "C" void kernel_launch(void* const* d_in, const int* in_sizes, int n_in, void* d_out, int out_size, void* d_ws, size_t ws_size, hipStream_t stream) {
    if (n_in != 26 || ws_size < WS_NEED) { fprintf(stderr, "kernel_launch: bad args n_in=%d ws=%zu need=%zu\n", n_in, ws_size, (size_t)WS_NEED); return; }
    Params p{};
    const float** pp = (const float**)&p;
    for (int i = 0; i < 26; ++i) pp[i] = (const float*)d_in[i];
    p.out = (float*)d_out; p.ws = (unsigned char*)d_ws;
    static int grid = 0;
#if MEGA
    if (!grid) {
        int dev = 0, cus = 0, per_cu = 0;
        (void)hipGetDevice(&dev);
        (void)hipDeviceGetAttribute(&cus, hipDeviceAttributeMultiprocessorCount, dev);
        (void)hipFuncSetAttribute((const void*)mega_kernel, hipFuncAttributeMaxDynamicSharedMemorySize, LDS_BYTES);
        (void)hipOccupancyMaxActiveBlocksPerMultiprocessor(&per_cu, (const void*)mega_kernel, NTHR, LDS_BYTES);
        if (per_cu < 1) per_cu = 1;
        grid = cus * 1;
        (void)per_cu;
    }
    (void)hipMemsetAsync((char*)d_ws + O_BARCTR, 0, XCD_BAR_WORDS * 4, stream);
    void* args[] = {(void*)&p};
    hipError_t e = hipLaunchCooperativeKernel((const void*)mega_kernel, dim3(grid), dim3(NTHR), args, LDS_BYTES, stream);
    if (e != hipSuccess) fprintf(stderr, "cooperative launch failed: %s (grid %d)\n", hipGetErrorString(e), grid);
#else
    if (!grid) {
        int dev = 0, cus = 0;
        (void)hipGetDevice(&dev);
        (void)hipDeviceGetAttribute(&cus, hipDeviceAttributeMultiprocessorCount, dev);
        grid = cus;
        launch_phases<0>(p, grid, stream, true);
    }
    launch_phases<0>(p, grid, stream, false);
#endif
}
```

```cpp
#include <hip/hip_runtime.h>
#include <hip/hip_cooperative_groups.h>
#include <cstdio>
#include <cstdint>
namespace cg = cooperative_groups;
namespace pg8 {
#define PG8_LAS __attribute__((address_space(3)))
typedef unsigned short bf16_t;
typedef short bf16x8 __attribute__((ext_vector_type(8)));
typedef float f32x4 __attribute__((ext_vector_type(4)));
typedef unsigned u32x4 __attribute__((ext_vector_type(4)));
constexpr int BM = 256, BK = 64, HALF = 128, HTB = HALF * BK * 2  , STAGE_BYTES = 8 * HTB, NXCD = 8, WGM = 8;

__host__ __device__ __forceinline__ int lds_byte(int r, int c) { const int st = (r >> 4) * 2 + (c >> 5), rr = r & 15, cc = c & 31, ob = rr * 64 + cc * 2; return st * 1024 + (ob ^ (((ob >> 9) & 1) << 5)); }
__host__ __device__ __forceinline__ void stage_rc(int b, int& R, int& C) { const int st = b / 1024, sb = b % 1024, swz = sb ^ (((sb >> 9) & 1) << 5); R = (st >> 1) * 16 + swz / 64; C = (st & 1) * 32 + (swz % 64) / 2; }
__host__ __device__ __forceinline__ int perm32(int rho) { const int n = rho >> 4, i = rho & 15; return 8 * (i >> 2) + 4 * n + (i & 3); }

struct Unit { int pm, pn; };
struct Gemm { const bf16_t* A; const bf16_t* Bt; int M, N, K; };

struct StaticOrder {
    int nM, nN, nwg, G, c;
    __host__ __device__ void init(int M, int N, int G_, int c_) { nM = M / BM; nN = N / BM; nwg = nM * nN; G = G_; c = c_; }
    __host__ __device__ bool next(int i, Unit& u) const {
        const long L = (long)i * G + c; if (L >= nwg) return false;
        int wgid = (int)L; { const int q = nwg / NXCD, r = nwg % NXCD, xcd = wgid % NXCD, off = wgid / NXCD; wgid = (xcd < r ? xcd * (q + 1) : r * (q + 1) + (xcd - r) * q) + off; }
        const int nig = WGM * nN, gid = wgid / nig, fm = gid * WGM, gsz = (nM - fm) < WGM ? (nM - fm) : WGM;
        u.pm = fm + ((wgid % nig) % gsz); u.pn = (wgid % nig) / gsz; return true;
    }
    __device__ __forceinline__ void a_ready(const Unit&) const {}
    __device__ __forceinline__ void done(const Unit&) const {}
};
template <class Epi, class Sched, bool ALIGN_EPI = false, bool SP2 = false>
__device__ __forceinline__ void gemm_phase(PG8_LAS unsigned char* lds, const Gemm g, const Sched& S, const Epi& E) {
    int tid_ = threadIdx.x; asm volatile("" : "+v"(tid_)); const int tid = tid_, wid = __builtin_amdgcn_readfirstlane(tid >> 6), lane = tid & 63, wr = wid >> 2, wc = wid & 3, fr = lane & 15, fq = lane >> 4;
    const int K = g.K, nt = K / BK;
    unsigned voffA[2], voffB[2];
#pragma unroll
    for (int i = 0; i < 2; ++i) { int R, C; stage_rc(tid * 16 + i * 8192, R, C); const int Rb = Epi::PERM ? ((R & ~31) + perm32(R & 31)) : R;
        voffA[i] = (unsigned)(R * K + C) * 2u; voffB[i] = (unsigned)(Rb * K + C) * 2u; }
    const size_t kstep = (size_t)(BK * 2);
    const size_t hstep = (size_t)HALF * K * 2;
    const size_t tstep = 2 * hstep;
    const unsigned ldsw = (unsigned)wid * 1024u;
    const int aoff = lds_byte(wr * 64 + fr, fq * 8), boff = lds_byte(wc * 32 + fr, fq * 8);
#define PG8_SA(b, h) (((b) * 2 + (h)) * HTB)
#define PG8_SB(b, h) ((4 + (b) * 2 + (h)) * HTB)
#define PG8_STAGE(bufoff, gbase, voff) do { _Pragma("unroll") for (int _i = 0; _i < 2; ++_i) \
        __builtin_amdgcn_global_load_lds((const unsigned*)((const char*)(gbase) + (voff)[_i]), (PG8_LAS unsigned*)(lds + (bufoff) + ldsw + _i * 8192), 16, 0, 0); } while (0)
#define PG8_LDA(dst, b, h) do { _Pragma("unroll") for (int m = 0; m < 4; ++m) _Pragma("unroll") for (int k = 0; k < 2; ++k) dst[m][k] = *(const PG8_LAS bf16x8*)(lds + PG8_SA(b, h) + aoff + m * 2048 + k * 1024); } while (0)
#define PG8_LDB(dst, b, h) do { _Pragma("unroll") for (int n = 0; n < 2; ++n) _Pragma("unroll") for (int k = 0; k < 2; ++k) dst[n][k] = *(const PG8_LAS bf16x8*)(lds + PG8_SB(b, h) + boff + n * 2048 + k * 1024); } while (0)
#define PG8_MMA(ai, bj, At, Bt) do { __builtin_amdgcn_s_setprio(1); _Pragma("unroll") for (int m = 0; m < 4; ++m) _Pragma("unroll") for (int n = 0; n < 2; ++n) _Pragma("unroll") for (int k = 0; k < 2; ++k) \
        acc[ai][bj][m][n] = __builtin_amdgcn_mfma_f32_16x16x32_bf16(Bt[n][k], At[m][k], acc[ai][bj][m][n], 0, 0, 0); __builtin_amdgcn_s_setprio(0); } while (0)
#define PG8_WAIT_V(n) asm volatile("s_waitcnt vmcnt(" #n ")" ::: "memory")
#define PG8_WAIT_L(n) asm volatile("s_waitcnt lgkmcnt(" #n ")" ::: "memory")
#define PG8_BAR __builtin_amdgcn_s_barrier()
#define PG8_SCHED __builtin_amdgcn_sched_barrier(0)
    Unit cur, nxt; int ui = 0;
    if (!S.next(0, cur)) return;
    f32x4 acc[2][2][4][2];
#pragma unroll
    for (int a = 0; a < 2; ++a)
#pragma unroll
        for (int b = 0; b < 2; ++b)
#pragma unroll
            for (int m = 0; m < 4; ++m)
#pragma unroll
                for (int n = 0; n < 2; ++n) acc[a][b][m][n] = (f32x4){0.f, 0.f, 0.f, 0.f};
    bf16x8 At[4][2], B0[2][2], B1[2][2];
    const char* cA = (const char*)g.A + (size_t)cur.pm * tstep; const char* cB = (const char*)g.Bt + (size_t)cur.pn * tstep;
    S.a_ready(cur);
    if constexpr (SP2) {
        PG8_STAGE(PG8_SB(0, 0), cB, voffB); PG8_STAGE(PG8_SB(0, 1), cB + hstep, voffB); PG8_STAGE(PG8_SA(0, 0), cA, voffA); PG8_STAGE(PG8_SA(0, 1), cA + hstep, voffA);
        if (wr == 1) PG8_BAR;
        PG8_WAIT_V(2); PG8_BAR;
        PG8_STAGE(PG8_SB(1, 0), cB + kstep, voffB); PG8_STAGE(PG8_SA(1, 0), cA + kstep, voffA); PG8_STAGE(PG8_SB(1, 1), cB + hstep + kstep, voffB);
        PG8_WAIT_V(6); PG8_BAR;
    } else {
        PG8_STAGE(PG8_SB(0, 0), cB, voffB); PG8_STAGE(PG8_SA(0, 0), cA, voffA); PG8_STAGE(PG8_SB(0, 1), cB + hstep, voffB); PG8_STAGE(PG8_SA(0, 1), cA + hstep, voffA);
        if (wr == 1) PG8_BAR;
        PG8_WAIT_V(4); PG8_BAR;
        PG8_STAGE(PG8_SB(1, 0), cB + kstep, voffB); PG8_STAGE(PG8_SA(1, 0), cA + kstep, voffA); PG8_STAGE(PG8_SB(1, 1), cB + hstep + kstep, voffB);
        PG8_WAIT_V(6); PG8_BAR;
    }
    for (;;) {
        const bool has_next = S.next(ui + 1, nxt);
        const char* nA = has_next ? (const char*)g.A + (size_t)nxt.pm * tstep : cA; const char* nB = has_next ? (const char*)g.Bt + (size_t)nxt.pn * tstep : cB;
        for (int t = 0; t < nt; t += 2) {
            const bool last = (t == nt - 2);
            const char* a1 = cA + (size_t)(t + 1) * kstep;
            const char* a2 = last ? nA : cA + (size_t)(t + 2) * kstep; const char* b2 = last ? nB : cB + (size_t)(t + 2) * kstep;
            const char* a3 = a2 + kstep; const char* b3 = b2 + kstep;
            if (last && has_next) S.a_ready(nxt);
            if constexpr (SP2) {
            PG8_LDB(B0, 0, 0); PG8_LDB(B1, 0, 1); PG8_SCHED; PG8_LDA(At, 0, 0); PG8_STAGE(PG8_SA(1, 1), a1 + hstep, voffA);
            PG8_WAIT_V(8); PG8_WAIT_L(0); PG8_BAR; PG8_MMA(0, 0, At, B0); PG8_MMA(0, 1, At, B1); PG8_BAR; PG8_SCHED;
            PG8_LDA(At, 0, 1); PG8_STAGE(PG8_SB(0, 0), b2, voffB); PG8_STAGE(PG8_SB(0, 1), b2 + hstep, voffB); PG8_STAGE(PG8_SA(0, 0), a2, voffA);
            PG8_WAIT_V(8); PG8_WAIT_L(0); PG8_BAR; PG8_MMA(1, 0, At, B0); PG8_MMA(1, 1, At, B1); PG8_BAR; PG8_SCHED;
            PG8_LDB(B0, 1, 0); PG8_LDB(B1, 1, 1); PG8_SCHED; PG8_LDA(At, 1, 0); PG8_STAGE(PG8_SA(0, 1), a2 + hstep, voffA);
            PG8_WAIT_V(8); PG8_WAIT_L(0); PG8_BAR; PG8_MMA(0, 0, At, B0); PG8_MMA(0, 1, At, B1); PG8_BAR; PG8_SCHED;
            PG8_LDA(At, 1, 1); PG8_STAGE(PG8_SB(1, 0), b3, voffB); PG8_STAGE(PG8_SB(1, 1), b3 + hstep, voffB); PG8_STAGE(PG8_SA(1, 0), a3, voffA);
            PG8_WAIT_V(8); PG8_WAIT_L(0); PG8_BAR; PG8_MMA(1, 0, At, B0); PG8_MMA(1, 1, At, B1); PG8_BAR; PG8_SCHED;
            } else {
            PG8_LDB(B0, 0, 0); PG8_SCHED; PG8_LDA(At, 0, 0); PG8_STAGE(PG8_SA(1, 1), a1 + hstep, voffA);
            PG8_WAIT_L(8); PG8_BAR; PG8_WAIT_L(0); PG8_MMA(0, 0, At, B0); PG8_BAR; PG8_SCHED;
            PG8_LDB(B1, 0, 1); PG8_STAGE(PG8_SB(0, 0), b2, voffB);
            PG8_BAR; PG8_WAIT_L(0); PG8_MMA(0, 1, At, B1); PG8_BAR;
            PG8_LDA(At, 0, 1); PG8_STAGE(PG8_SA(0, 0), a2, voffA);
            PG8_BAR; PG8_WAIT_L(0); PG8_MMA(1, 0, At, B0); PG8_BAR; PG8_SCHED;
            PG8_STAGE(PG8_SB(0, 1), b2 + hstep, voffB);
            PG8_WAIT_V(6); PG8_BAR; PG8_MMA(1, 1, At, B1); PG8_BAR;
            PG8_LDB(B0, 1, 0); PG8_SCHED; PG8_LDA(At, 1, 0); PG8_STAGE(PG8_SA(0, 1), a2 + hstep, voffA);
            PG8_WAIT_L(8); PG8_BAR; PG8_WAIT_L(0); PG8_MMA(0, 0, At, B0); PG8_BAR; PG8_SCHED;
            PG8_LDB(B1, 1, 1); PG8_STAGE(PG8_SB(1, 0), b3, voffB);
            PG8_BAR; PG8_WAIT_L(0); PG8_MMA(0, 1, At, B1); PG8_BAR;
            PG8_LDA(At, 1, 1); PG8_STAGE(PG8_SA(1, 0), a3, voffA);
            PG8_BAR; PG8_WAIT_L(0); PG8_MMA(1, 0, At, B0); PG8_BAR; PG8_SCHED;
            PG8_STAGE(PG8_SB(1, 1), b3 + hstep, voffB);
            PG8_WAIT_V(6); PG8_BAR; PG8_MMA(1, 1, At, B1); PG8_BAR;
            }
        }
        if constexpr (ALIGN_EPI) { if (wr == 0) PG8_BAR; }
        if constexpr (!Epi::AFTER_DRAIN) { E(acc, cur, wr, wc, fr, fq); S.done(cur); }
        if (!has_next) break;
#pragma unroll
        for (int a = 0; a < 2; ++a)
#pragma unroll
            for (int b = 0; b < 2; ++b)
#pragma unroll
                for (int m = 0; m < 4; ++m)
#pragma unroll
                    for (int n = 0; n < 2; ++n) acc[a][b][m][n] = (f32x4){0.f, 0.f, 0.f, 0.f};
        cur = nxt; cA = nA; cB = nB; ++ui;
        if constexpr (ALIGN_EPI) { if (wr == 1) PG8_BAR; }
    }
    PG8_WAIT_V(0);
    if constexpr (!ALIGN_EPI) { if (wr == 0) PG8_BAR; }
    PG8_BAR;
    if constexpr (Epi::AFTER_DRAIN) { E.fused(acc, cur, wr, wc, fr, fq, lds, wid, lane); S.done(cur); }
#undef PG8_SA
#undef PG8_SB
#undef PG8_STAGE
#undef PG8_LDA
#undef PG8_LDB
#undef PG8_MMA
#undef PG8_WAIT_V
#undef PG8_WAIT_L
#undef PG8_BAR
#undef PG8_SCHED
}
}

using pg8::bf16_t; using pg8::bf16x8; using pg8::f32x4; using pg8::u32x4; using pg8::Unit;
typedef unsigned u32x2 __attribute__((ext_vector_type(2)));
typedef float f32x2 __attribute__((ext_vector_type(2)));
#define DI __device__ __forceinline__

constexpr int L_ = 8192, D_ = 2048;
constexpr int NTHR = 512;
constexpr int LDS_BYTES = 155648 + 256;

constexpr size_t O_WGIN = 0;
constexpr size_t O_WGOUT = O_WGIN + (size_t)12544 * 2048 * 2;
constexpr size_t SZ_WFIN = (size_t)11264 * 2048 * 2;
constexpr size_t O_WFIN = O_WGOUT + (size_t)2048 * 4096 * 2;
constexpr size_t SZ_WFOUT = (size_t)2048 * 5632 * 2;
constexpr size_t O_WFOUT = O_WFIN + 2 * SZ_WFIN;
constexpr size_t O_WKV = O_WFOUT + 2 * SZ_WFOUT;
constexpr size_t O_WXIN = O_WKV + (size_t)1280 * 2048 * 2;
constexpr size_t O_WXOUT = O_WXIN + (size_t)8192 * 2048 * 2;
constexpr size_t O_MODP = O_WXOUT + (size_t)2048 * 4096 * 2;
constexpr size_t O_MOD = O_MODP + (size_t)16 * 32768 * 4;
constexpr size_t O_SMALL = O_MOD + (size_t)32768 * 4;
constexpr size_t O_XS = O_SMALL + (size_t)65536 * 4;
constexpr size_t O_H = O_XS + (size_t)L_ * 2048 * 4;
constexpr size_t O_H2 = O_H + (size_t)L_ * 2048 * 2;
constexpr size_t O_BIG = O_H2 + (size_t)L_ * 2048 * 2;
constexpr size_t O_QKVRAW = O_BIG;
constexpr size_t O_Z = O_QKVRAW + (size_t)L_ * 8192 * 2;
constexpr size_t O_BA = O_Z + (size_t)L_ * 4096 * 2;
constexpr size_t O_KN = O_BA + (size_t)L_ * 64 * 4;
constexpr size_t O_QN = O_KN + (size_t)L_ * 2048 * 4;
constexpr size_t O_VV = O_QN + (size_t)L_ * 2048 * 2;
constexpr size_t O_BETA = O_VV + (size_t)L_ * 4096 * 2;
constexpr size_t O_GG = O_BETA + (size_t)L_ * 32 * 4;
constexpr size_t O_GDN_END = O_GG + (size_t)L_ * 32 * 4;
constexpr size_t O_PA_HK = O_XS;
constexpr size_t O_PA_HV = O_KN;
constexpr size_t O_PA_G = O_GDN_END;
constexpr size_t O_PA_END = O_PA_G + (size_t)4096 * 192 * 4;
static_assert(O_PA_HV + (size_t)4096 * 40960 <= O_BETA, "PA_HV overflows");
constexpr size_t O_ORAW = O_H;
constexpr size_t O_OG = O_QKVRAW;
constexpr size_t O_HID = O_BIG;
constexpr size_t O_QRAW = O_BIG;
constexpr size_t O_GSIG = O_QRAW + (size_t)L_ * 4096 * 2;
constexpr size_t O_KVRAW = O_GSIG + (size_t)L_ * 4096 * 2;
constexpr size_t O_KB = O_KVRAW + (size_t)L_ * 1280 * 4;
constexpr size_t O_VB = O_KB + (size_t)L_ * 512 * 2;
constexpr size_t O_FCUM = O_VB + (size_t)L_ * 512 * 2;
constexpr size_t O_OG2 = O_FCUM + (size_t)L_ * 16 * 4;
constexpr size_t O_FOX_END = O_OG2 + (size_t)L_ * 4096 * 2;
constexpr size_t WS_NEED = O_PA_END > O_FOX_END ? O_PA_END : O_FOX_END;

constexpr size_t O_BARCTR = O_SMALL + (size_t)48000 * 4;
constexpr int S_NORM_MIX = 0, S_NORM_FFN = 4096, S_CONV = 8192, S_ALOG = 40960, S_DTB = 41024, S_GNORM = 41088, S_KVNORM = 41216, S_KNORM = 43264, S_FB = 43520, S_QNORM = 43584, S_ONORM = 43840;
struct Params {
    const float *x, *c, *ada_w, *ada_b, *norm_mix, *norm_ffn, *ffn_w_in, *ffn_w_out, *gdn_w_in, *gdn_conv, *gdn_a_log, *gdn_dt_bias, *gdn_norm, *gdn_w_out,
        *kv_ada_w, *kv_ada_b, *kv_norm, *kv_w, *k_norm, *forget_b, *fox_w_in, *q_norm, *fox_w_out, *out_ada_w, *out_ada_b, *out_norm;
    float* out; unsigned char* ws;
};

DI f32x4 mfma16(bf16x8 a, bf16x8 b, f32x4 c) { return __builtin_amdgcn_mfma_f32_16x16x32_bf16(a, b, c, 0, 0, 0); }
DI int ltid() { int t = threadIdx.x; asm volatile("" : "+v"(t)); return t; }
DI unsigned pk2(float lo, float hi) { unsigned r; asm volatile("v_cvt_pk_bf16_f32 %0, %1, %2" : "=v"(r) : "v"(lo), "v"(hi)); return r; }
DI float bf2f(bf16_t b) { return __uint_as_float(((unsigned)b) << 16); }
DI float bflo(unsigned w) { return __uint_as_float(w << 16); }
DI float bfhi(unsigned w) { return __uint_as_float(w & 0xffff0000u); }
DI float wave_sum(float v) { v += __shfl_xor(v, 32); v += __shfl_xor(v, 16); v += __shfl_xor(v, 8); v += __shfl_xor(v, 4); v += __shfl_xor(v, 2); v += __shfl_xor(v, 1); return v; }
DI float wave_max(float v) { v = fmaxf(v, __shfl_xor(v, 32)); v = fmaxf(v, __shfl_xor(v, 16)); v = fmaxf(v, __shfl_xor(v, 8)); v = fmaxf(v, __shfl_xor(v, 4)); v = fmaxf(v, __shfl_xor(v, 2)); v = fmaxf(v, __shfl_xor(v, 1)); return v; }
DI float siluf(float x) { return x / (1.0f + expf(-x)); }
DI float sigmf(float x) { return 1.0f / (1.0f + expf(-x)); }
DI float sigm_fast(float x) { return __builtin_amdgcn_rcpf(1.0f + __builtin_amdgcn_exp2f(-1.4426950408889634f * x)); }
DI float silu_fast(float x) { return x * sigm_fast(x); }
DI float softplusf(float x) { return fmaxf(x, 0.f) + log1pf(expf(-fabsf(x))); }

struct EpiGdnIn {
    static constexpr bool PERM = true, AFTER_DRAIN = false;
    bf16_t* qkv; bf16_t* z; float* ba;
    DI void operator()(const f32x4 (&acc)[2][2][4][2], const Unit& u, int wr, int wc, int fr, int fq) const {
        const int row0 = u.pm * 256 + wr * 64 + fr;
        if (u.pn < 48) {
            bf16_t* base; int ldc, colt;
            if (u.pn < 32) { base = qkv; ldc = 8192; colt = u.pn * 256; } else { base = z; ldc = 4096; colt = (u.pn - 32) * 256; }
            const int col0 = colt + wc * 32 + 8 * fq;
#pragma unroll
            for (int ai = 0; ai < 2; ++ai)
#pragma unroll
                for (int m = 0; m < 4; ++m) { bf16_t* rowp = base + (size_t)(row0 + ai * 128 + m * 16) * ldc + col0;
#pragma unroll
                    for (int bj = 0; bj < 2; ++bj) { const f32x4 v0 = acc[ai][bj][m][0], v1 = acc[ai][bj][m][1];
                        u32x4 w; w.x = pk2(v0[0], v0[1]); w.y = pk2(v0[2], v0[3]); w.z = pk2(v1[0], v1[1]); w.w = pk2(v1[2], v1[3]);
                        *(u32x4*)(rowp + bj * 128) = w; } }
        } else if (wc < 2) {
#pragma unroll
            for (int ai = 0; ai < 2; ++ai)
#pragma unroll
                for (int m = 0; m < 4; ++m) { float* rowp = ba + (size_t)(row0 + ai * 128 + m * 16) * 64 + wc * 32 + 8 * fq;
                    *(f32x4*)rowp = acc[ai][0][m][0]; *(f32x4*)(rowp + 4) = acc[ai][0][m][1]; }
        }
    }
};
struct EpiResid {
    static constexpr bool PERM = false, AFTER_DRAIN = false;
    const float* base; float* out; const float* gate;
    DI void operator()(const f32x4 (&acc)[2][2][4][2], const Unit& u, int wr, int wc, int fr, int fq) const {
        const int row0 = u.pm * 256 + wr * 64 + fr, col0 = u.pn * 256 + wc * 32 + 4 * fq;
        f32x4 gv[2][2];
#pragma unroll
        for (int bj = 0; bj < 2; ++bj)
#pragma unroll
            for (int n = 0; n < 2; ++n) gv[bj][n] = *(const f32x4*)(gate + col0 + bj * 128 + n * 16);
#pragma unroll
        for (int ai = 0; ai < 2; ++ai)
#pragma unroll
            for (int m = 0; m < 4; ++m) { const size_t off = (size_t)(row0 + ai * 128 + m * 16) * 2048 + col0;
#pragma unroll
                for (int bj = 0; bj < 2; ++bj)
#pragma unroll
                    for (int n = 0; n < 2; ++n) { const f32x4 b = *(const f32x4*)(base + off + bj * 128 + n * 16);
                        *(f32x4*)(out + off + bj * 128 + n * 16) = b + gv[bj][n] * acc[ai][bj][m][n]; } }
    }
};
struct EpiSwiglu {
    static constexpr bool PERM = true, AFTER_DRAIN = false;
    bf16_t* hid;
    DI void operator()(const f32x4 (&acc)[2][2][4][2], const Unit& u, int wr, int wc, int fr, int fq) const {
        const int row0 = u.pm * 256 + wr * 64 + fr, col0 = u.pn * 128 + wc * 32 + 8 * fq;
#pragma unroll
        for (int ai = 0; ai < 2; ++ai)
#pragma unroll
            for (int m = 0; m < 4; ++m) { bf16_t* rowp = hid + (size_t)(row0 + ai * 128 + m * 16) * 5632 + col0;
                const f32x4 g0 = acc[ai][0][m][0], g1 = acc[ai][0][m][1], u0 = acc[ai][1][m][0], u1 = acc[ai][1][m][1];
                float h[8];
#pragma unroll
                for (int j = 0; j < 4; ++j) { h[j] = silu_fast(g0[j]) * u0[j]; h[4 + j] = silu_fast(g1[j]) * u1[j]; }
                u32x4 w; w.x = pk2(h[0], h[1]); w.y = pk2(h[2], h[3]); w.z = pk2(h[4], h[5]); w.w = pk2(h[6], h[7]);
                *(u32x4*)rowp = w; }
    }
};
struct EpiKV {
    static constexpr bool PERM = false, AFTER_DRAIN = false;
    float* kv;
    DI void operator()(const f32x4 (&acc)[2][2][4][2], const Unit& u, int wr, int wc, int fr, int fq) const {
        const int row0 = u.pm * 256 + wr * 64 + fr, col0 = u.pn * 256 + wc * 32 + 4 * fq;
#pragma unroll
        for (int ai = 0; ai < 2; ++ai)
#pragma unroll
            for (int m = 0; m < 4; ++m) { float* rowp = kv + (size_t)(row0 + ai * 128 + m * 16) * 1280 + col0;
#pragma unroll
                for (int bj = 0; bj < 2; ++bj)
#pragma unroll
                    for (int n = 0; n < 2; ++n) *(f32x4*)(rowp + bj * 128 + n * 16) = acc[ai][bj][m][n]; }
    }
};
struct EpiFoxIn {
    static constexpr bool PERM = true, AFTER_DRAIN = false;
    bf16_t* qraw; bf16_t* gsig;
    DI void operator()(const f32x4 (&acc)[2][2][4][2], const Unit& u, int wr, int wc, int fr, int fq) const {
        const int row0 = u.pm * 256 + wr * 64 + fr;
        const bool isg = u.pn >= 16;
        bf16_t* base = isg ? gsig : qraw;
        const int col0 = (isg ? u.pn - 16 : u.pn) * 256 + wc * 32 + 8 * fq;
#pragma unroll
        for (int ai = 0; ai < 2; ++ai)
#pragma unroll
            for (int m = 0; m < 4; ++m) { bf16_t* rowp = base + (size_t)(row0 + ai * 128 + m * 16) * 4096 + col0;
#pragma unroll
                for (int bj = 0; bj < 2; ++bj) { f32x4 v0 = acc[ai][bj][m][0], v1 = acc[ai][bj][m][1];
                    if (isg) {
#pragma unroll
                        for (int j = 0; j < 4; ++j) { v0[j] = sigm_fast(v0[j]); v1[j] = sigm_fast(v1[j]); } }
                    u32x4 w; w.x = pk2(v0[0], v0[1]); w.y = pk2(v0[2], v0[3]); w.z = pk2(v1[0], v1[1]); w.w = pk2(v1[2], v1[3]);
                    *(u32x4*)(rowp + bj * 128) = w; } }
    }
};

template <class Epi>
DI void run_gemm(unsigned char* lds, const bf16_t* A, const bf16_t* Bt, int N, int K, const Epi& E) {
    pg8::Gemm g{A, Bt, L_, N, K};
    int bid_ = blockIdx.x, gd_ = gridDim.x; asm volatile("" : "+s"(bid_), "+s"(gd_));
    pg8::StaticOrder S; S.init(L_, N, gd_, bid_);
    pg8::gemm_phase<Epi, pg8::StaticOrder, true, true>((PG8_LAS unsigned char*)lds, g, S, E);
    __syncthreads();
}

DI void phase_ba(const bf16_t* H, const bf16_t* Wt, float* ba) { const int TIDX = ltid();
    const int wid = TIDX >> 6, lane = TIDX & 63, l15 = lane & 15, quad = lane >> 4;
    for (int item = blockIdx.x; item < 256; item += gridDim.x) {
        const bf16_t* ap = H + (size_t)(item * 32 + (wid >> 2) * 16 + l15) * 2048 + quad * 8;
        const bf16_t* bp = Wt + (size_t)(12288 + (wid & 3) * 16 + l15) * 2048 + quad * 8;
        f32x4 acc0 = (f32x4){0.f, 0.f, 0.f, 0.f}, acc1 = acc0;
#pragma unroll 4
        for (int k = 0; k < 2048; k += 64) {
            const bf16x8 a0 = *(const bf16x8*)(ap + k), b0 = *(const bf16x8*)(bp + k), a1 = *(const bf16x8*)(ap + k + 32), b1 = *(const bf16x8*)(bp + k + 32);
            acc0 = mfma16(a0, b0, acc0); acc1 = mfma16(a1, b1, acc1); }
        acc0 += acc1;
        float* op = ba + (size_t)(item * 32 + (wid >> 2) * 16 + quad * 4) * 64 + (wid & 3) * 16 + l15;
#pragma unroll
        for (int j = 0; j < 4; ++j) op[j * 64] = acc0[j];
    }
}

struct WD { const float* src; bf16_t* dst; int K, N, Npad, mode; };
DI WD get_wd(const Params& p, int i) {
    unsigned char* ws = p.ws;
    switch (i) {
        case 0: return WD{p.gdn_w_in, (bf16_t*)(ws + O_WGIN), 2048, 12352, 12544, 0};
        case 1: return WD{p.gdn_w_out, (bf16_t*)(ws + O_WGOUT), 4096, 2048, 2048, 0};
        case 2: return WD{p.ffn_w_in, (bf16_t*)(ws + O_WFIN), 2048, 11264, 11264, 1};
        case 3: return WD{p.ffn_w_in + (size_t)2048 * 11264, (bf16_t*)(ws + O_WFIN + SZ_WFIN), 2048, 11264, 11264, 1};
        case 4: return WD{p.ffn_w_out, (bf16_t*)(ws + O_WFOUT), 5632, 2048, 2048, 0};
        case 5: return WD{p.ffn_w_out + (size_t)5632 * 2048, (bf16_t*)(ws + O_WFOUT + SZ_WFOUT), 5632, 2048, 2048, 0};
        case 6: return WD{p.kv_w, (bf16_t*)(ws + O_WKV), 2048, 1040, 1280, 0};
        case 7: return WD{p.fox_w_in, (bf16_t*)(ws + O_WXIN), 2048, 8192, 8192, 0};
        default: return WD{p.fox_w_out, (bf16_t*)(ws + O_WXOUT), 4096, 2048, 2048, 0};
    }
}
DI int wrow(int n, int mode) {
    if (mode == 1) { if (n < 5632) return (n >> 7) * 256 + (n & 127); const int m = n - 5632; return (m >> 7) * 256 + 128 + (m & 127); }
    return n;
}
DI void convert_load(const WD& d, int j, int tid, f32x4 (&v)[2]) {
    const int nkt = d.K / 64, k0 = (j % nkt) * 64, n0 = (j / nkt) * 64;
#pragma unroll
    for (int i = 0; i < 2; ++i) { const int kk = (tid >> 4) + i * 32, n4 = (tid & 15) * 4;
        v[i] = (f32x4){0.f, 0.f, 0.f, 0.f};
        if (n0 + n4 < d.N) v[i] = *(const f32x4*)(d.src + (size_t)(k0 + kk) * d.N + n0 + n4); }
}
DI void convert_store(const WD& d, int j, int tid, const f32x4 (&v)[2], float* tile  ) {
    const int nkt = d.K / 64, k0 = (j % nkt) * 64, n0 = (j / nkt) * 64;
    __syncthreads();
#pragma unroll
    for (int i = 0; i < 2; ++i) { const int kk = (tid >> 4) + i * 32, n4 = (tid & 15) * 4;
        tile[(n4 + 0) * 65 + kk] = v[i][0]; tile[(n4 + 1) * 65 + kk] = v[i][1]; tile[(n4 + 2) * 65 + kk] = v[i][2]; tile[(n4 + 3) * 65 + kk] = v[i][3]; }
    __syncthreads();
    const int n = tid >> 3, k8 = (tid & 7) * 8;
    const float* r = tile + n * 65 + k8;
    u32x4 w; w.x = pk2(r[0], r[1]); w.y = pk2(r[2], r[3]); w.z = pk2(r[4], r[5]); w.w = pk2(r[6], r[7]);
    *(u32x4*)(d.dst + (size_t)wrow(n0 + n, d.mode) * d.K + k0 + k8) = w;
}
DI void phase_convert(const Params& p, unsigned char* lds, int bid, int nb, int dlo, int dhi) { const int TIDX = ltid();
    float* tile = (float*)lds;
    int base = 0;
    for (int i = dlo; i < dhi; ++i) {
        const WD d = get_wd(p, i);
        const int cnt = (d.K / 64) * (d.Npad / 64);
        int first = bid - (base % nb); if (first < 0) first += nb;
        f32x4 va[2], vb[2];
        int j = first;
        if (j < cnt) convert_load(d, j, TIDX, va);
        for (; j < cnt; j += 2 * nb) {
            const int j2 = j + nb, j3 = j2 + nb;
            if (j2 < cnt) convert_load(d, j2, TIDX, vb);
            convert_store(d, j, TIDX, va, tile);
            if (j3 < cnt) convert_load(d, j3, TIDX, va);
            if (j2 < cnt) convert_store(d, j2, TIDX, vb, tile);
        }
        base += cnt;
    }
    __syncthreads();
}
DI void phase_adaln(const Params& p, unsigned char* lds, int bid, int nb, int cb0, int ncb) { const int TIDX = ltid();
    float* cs = (float*)lds;
    float* modp = (float*)(p.ws + O_MODP);
    for (int item = bid; item < ncb * 16; item += nb) {
        const int cb = cb0 + item % ncb, ks = item / ncb;
        const int col = cb * 512 + TIDX;
        const float* W; int Nm, jm;
        if (col < 24576) { const int l = col >= 12288 ? 1 : 0; W = p.ada_w + (size_t)l * 2048 * 12288; Nm = 12288; jm = col - l * 12288; }
        else if (col < 28672) { W = p.kv_ada_w; Nm = 4096; jm = col - 24576; }
        else { W = p.out_ada_w; Nm = 4096; jm = col - 28672; }
        __syncthreads();
        if (TIDX < 128) cs[TIDX] = siluf(p.c[ks * 128 + TIDX]);
        __syncthreads();
        const float* wp = W + (size_t)(ks * 128) * Nm + jm;
        float a0 = 0.f, a1 = 0.f, a2 = 0.f, a3 = 0.f;
#pragma unroll 1
        for (int k0 = 0; k0 < 128; k0 += 32) {
            float wv[32];
#pragma unroll
            for (int k = 0; k < 32; ++k) wv[k] = wp[(size_t)(k0 + k) * Nm];
#pragma unroll
            for (int k = 0; k < 32; k += 4) { a0 += cs[k0 + k] * wv[k]; a1 += cs[k0 + k + 1] * wv[k + 1]; a2 += cs[k0 + k + 2] * wv[k + 2]; a3 += cs[k0 + k + 3] * wv[k + 3]; }
        }
        modp[ks * 32768 + col] = (a0 + a1) + (a2 + a3);
    }
    __syncthreads();
}
DI void copy_vec(const float* src, float* dst, int n) { const int TIDX = ltid(); for (int i = blockIdx.x * NTHR + TIDX; i < n; i += gridDim.x * NTHR) dst[i] = src[i]; }
DI void phase_copysmall(const Params& p) {
    float* sm = (float*)(p.ws + O_SMALL);
    copy_vec(p.norm_mix, sm + S_NORM_MIX, 4096); copy_vec(p.norm_ffn, sm + S_NORM_FFN, 4096); copy_vec(p.gdn_conv, sm + S_CONV, 32768);
    copy_vec(p.gdn_a_log, sm + S_ALOG, 32); copy_vec(p.gdn_dt_bias, sm + S_DTB, 32); copy_vec(p.gdn_norm, sm + S_GNORM, 128);
    copy_vec(p.kv_norm, sm + S_KVNORM, 2048); copy_vec(p.k_norm, sm + S_KNORM, 256); copy_vec(p.forget_b, sm + S_FB, 16);
    copy_vec(p.q_norm, sm + S_QNORM, 256); copy_vec(p.out_norm, sm + S_ONORM, 2048);
}
DI void phase_modreduce(const Params& p, int col0, int col1) { const int TIDX = ltid();
    const float* modp = (const float*)(p.ws + O_MODP);
    float* mod = (float*)(p.ws + O_MOD);
    for (int col = col0 + blockIdx.x * NTHR + TIDX; col < col1; col += gridDim.x * NTHR) {
        float s = col < 24576 ? p.ada_b[col] : (col < 28672 ? p.kv_ada_b[col - 24576] : p.out_ada_b[col - 28672]);
#pragma unroll
        for (int k = 0; k < 16; ++k) s += modp[k * 32768 + col];
        mod[col] = s;
    }
}

DI void phase_normmod(const float* x, const float* w1, const float* sh1, const float* sc1, bf16_t* o1,
                      const float* w2, const float* sh2, const float* sc2, bf16_t* o2, float* xcopy = nullptr) { const int TIDX = ltid();
    const int wid = TIDX >> 6, lane = TIDX & 63;
    for (int r = (blockIdx.x * 8 + wid) * 2; r < L_; r += gridDim.x * 16) {
        const float* xr = x + (size_t)r * 2048;
        f32x4 va[8], vb[8]; float sa = 0.f, sb = 0.f;
#pragma unroll
        for (int i = 0; i < 8; ++i) { va[i] = *(const f32x4*)(xr + i * 256 + lane * 4); vb[i] = *(const f32x4*)(xr + 2048 + i * 256 + lane * 4); }
#pragma unroll
        for (int i = 0; i < 8; ++i) { sa += va[i][0] * va[i][0] + va[i][1] * va[i][1] + va[i][2] * va[i][2] + va[i][3] * va[i][3];
                                      sb += vb[i][0] * vb[i][0] + vb[i][1] * vb[i][1] + vb[i][2] * vb[i][2] + vb[i][3] * vb[i][3]; }
#pragma unroll
        for (int d = 32; d >= 1; d >>= 1) { sa += __shfl_xor(sa, d); sb += __shfl_xor(sb, d); }
        const float ra = 1.0f / sqrtf(sa * (1.0f / 2048.0f) + 1e-6f), rb = 1.0f / sqrtf(sb * (1.0f / 2048.0f) + 1e-6f);
        if (xcopy) {
#pragma unroll
            for (int i = 0; i < 8; ++i) { *(f32x4*)(xcopy + (size_t)r * 2048 + i * 256 + lane * 4) = va[i]; *(f32x4*)(xcopy + (size_t)(r + 1) * 2048 + i * 256 + lane * 4) = vb[i]; } }
#pragma unroll
        for (int i = 0; i < 8; ++i) { const int c = i * 256 + lane * 4;
            const f32x4 wv = *(const f32x4*)(w1 + c), sh = *(const f32x4*)(sh1 + c), sc = *(const f32x4*)(sc1 + c) + 1.0f;
            const f32x4 ya = (va[i] * ra * wv) * sc + sh, yb = (vb[i] * rb * wv) * sc + sh;
            u32x2 oa; oa.x = pk2(ya[0], ya[1]); oa.y = pk2(ya[2], ya[3]); u32x2 ob; ob.x = pk2(yb[0], yb[1]); ob.y = pk2(yb[2], yb[3]);
            *(u32x2*)(o1 + (size_t)r * 2048 + c) = oa; *(u32x2*)(o1 + (size_t)(r + 1) * 2048 + c) = ob; }
        if (o2) {
#pragma unroll
            for (int i = 0; i < 8; ++i) { const int c = i * 256 + lane * 4;
                const f32x4 wv = *(const f32x4*)(w2 + c), sh = *(const f32x4*)(sh2 + c), sc = *(const f32x4*)(sc2 + c) + 1.0f;
                const f32x4 ya = (va[i] * ra * wv) * sc + sh, yb = (vb[i] * rb * wv) * sc + sh;
                u32x2 oa; oa.x = pk2(ya[0], ya[1]); oa.y = pk2(ya[2], ya[3]); u32x2 ob; ob.x = pk2(yb[0], yb[1]); ob.y = pk2(yb[2], yb[3]);
                *(u32x2*)(o2 + (size_t)r * 2048 + c) = oa; *(u32x2*)(o2 + (size_t)(r + 1) * 2048 + c) = ob; }
        }
    }
}
DI void phase_final(const float* x, const float* w1, const float* sh1, const float* sc1, float* out) { const int TIDX = ltid();
    const int wid = TIDX >> 6, lane = TIDX & 63;
    for (int r = (blockIdx.x * 8 + wid) * 2; r < L_; r += gridDim.x * 16) {
        const float* xr = x + (size_t)r * 2048;
        f32x4 va[8], vb[8]; float sa = 0.f, sb = 0.f;
#pragma unroll
        for (int i = 0; i < 8; ++i) { va[i] = *(const f32x4*)(xr + i * 256 + lane * 4); vb[i] = *(const f32x4*)(xr + 2048 + i * 256 + lane * 4); }
#pragma unroll
        for (int i = 0; i < 8; ++i) { sa += va[i][0] * va[i][0] + va[i][1] * va[i][1] + va[i][2] * va[i][2] + va[i][3] * va[i][3];
                                      sb += vb[i][0] * vb[i][0] + vb[i][1] * vb[i][1] + vb[i][2] * vb[i][2] + vb[i][3] * vb[i][3]; }
#pragma unroll
        for (int d = 32; d >= 1; d >>= 1) { sa += __shfl_xor(sa, d); sb += __shfl_xor(sb, d); }
        const float ra = 1.0f / sqrtf(sa * (1.0f / 2048.0f) + 1e-6f), rb = 1.0f / sqrtf(sb * (1.0f / 2048.0f) + 1e-6f);
#pragma unroll
        for (int i = 0; i < 8; ++i) { const int c = i * 256 + lane * 4;
            const f32x4 wv = *(const f32x4*)(w1 + c), sh = *(const f32x4*)(sh1 + c), sc = *(const f32x4*)(sc1 + c) + 1.0f;
            *(f32x4*)(out + (size_t)r * 2048 + c) = (va[i] * ra * wv) * sc + sh; *(f32x4*)(out + (size_t)(r + 1) * 2048 + c) = (vb[i] * rb * wv) * sc + sh; }
    }
}

DI void phase_conv(const Params& p) { const int TIDX = ltid();
    const bf16_t* raw = (const bf16_t*)(p.ws + O_QKVRAW);
    const float* ba = (const float*)(p.ws + O_BA);
    float* KN = (float*)(p.ws + O_KN); bf16_t* QN = (bf16_t*)(p.ws + O_QN); bf16_t* VV = (bf16_t*)(p.ws + O_VV);
    float* BETA = (float*)(p.ws + O_BETA); float* GG = (float*)(p.ws + O_GG);
    const float* sm = (const float*)(p.ws + O_SMALL);
    const float* cw = sm + S_CONV;
    const int wid = TIDX >> 6, lane = TIDX & 63;
    for (int e = blockIdx.x * NTHR + TIDX; e < L_ * 64; e += gridDim.x * NTHR) {
        const int t = e >> 6, cidx = e & 63; const float v = ba[e];
        if (cidx < 32) BETA[t * 32 + cidx] = sigmf(v);
        else { const int h = cidx - 32; GG[t * 32 + h] = -expf(sm[S_ALOG + h]) * softplusf(v + sm[S_DTB + h]); }
    }
    for (int item = blockIdx.x * 8 + wid; item < 1024 * 64; item += gridDim.x * 8) {
        const int g = item & 63, tb = item >> 6, t0 = tb * 8;
        const int c = g * 128 + lane * 2;
        unsigned xr[11];
#pragma unroll
        for (int i = 0; i < 11; ++i) { const int tt = t0 - 3 + i; xr[i] = (tt >= 0) ? *(const unsigned*)(raw + (size_t)tt * 8192 + c) : 0u; }
        f32x2 w[4];
#pragma unroll
        for (int j = 0; j < 4; ++j) w[j] = *(const f32x2*)(cw + j * 8192 + c);
        float a0[8], a1[8];
#pragma unroll
        for (int i = 0; i < 8; ++i) { float s0 = 0.f, s1 = 0.f;
#pragma unroll
            for (int j = 0; j < 4; ++j) { s0 += w[j].x * bflo(xr[i + j]); s1 += w[j].y * bfhi(xr[i + j]); }
            a0[i] = silu_fast(s0); a1[i] = silu_fast(s1); }
        if (g < 32) {
            float ss[8];
#pragma unroll
            for (int i = 0; i < 8; ++i) ss[i] = a0[i] * a0[i] + a1[i] * a1[i];
#pragma unroll
            for (int d = 32; d >= 1; d >>= 1) {
#pragma unroll
                for (int i = 0; i < 8; ++i) ss[i] += __shfl_xor(ss[i], d); }
#pragma unroll
            for (int i = 0; i < 8; ++i) { const float r = 1.0f / sqrtf(ss[i] + 1e-6f); const int t = t0 + i;
                if (g < 16) { const float s = 0.08838834764831845f * r; *(unsigned*)(QN + (size_t)t * 2048 + g * 128 + lane * 2) = pk2(a0[i] * s, a1[i] * s); }
                else { f32x2 o; o.x = a0[i] * r; o.y = a1[i] * r; *(f32x2*)(KN + (size_t)t * 2048 + (g - 16) * 128 + lane * 2) = o; } }
        } else {
#pragma unroll
            for (int i = 0; i < 8; ++i) *(unsigned*)(VV + (size_t)(t0 + i) * 4096 + (g - 32) * 128 + lane * 2) = pk2(a0[i], a1[i]);
        }
    }
}

DI void phase_gdn_recurrent(const Params& p, unsigned char* lds) { const int TIDX = ltid();
    if (blockIdx.x < 16) {
        const float* KN = (const float*)(p.ws + O_KN); const bf16_t* QN = (const bf16_t*)(p.ws + O_QN); const bf16_t* VV = (const bf16_t*)(p.ws + O_VV);
        const float* BETA = (const float*)(p.ws + O_BETA); const float* GG = (const float*)(p.ws + O_GG);
        float* ORAW = (float*)(p.ws + O_QKVRAW);
        const int b = blockIdx.x, tid = TIDX, hl = tid >> 8, col = (tid >> 1) & 127, half = tid & 1, hv = 2 * b + hl;
        float* kb = (float*)lds;
        float* qb = kb + 16 * 128;
        float* vb = qb + 16 * 128;
        float* bb = vb + 16 * 256;
        float* gb = bb + 32;
        float S[64];
#pragma unroll
        for (int k = 0; k < 64; ++k) S[k] = 0.f;
        for (int t0 = 0; t0 < L_; t0 += 16) {
            __syncthreads();
#pragma unroll
            for (int i = 0; i < 4; ++i) { const int e = tid + i * 512, tt = e >> 7, r = e & 127;
                kb[e] = KN[(size_t)(t0 + tt) * 2048 + b * 128 + r]; qb[e] = bf2f(QN[(size_t)(t0 + tt) * 2048 + b * 128 + r]); }
#pragma unroll
            for (int i = 0; i < 8; ++i) { const int e = tid + i * 512, tt = e >> 8, r = e & 255; vb[e] = bf2f(VV[(size_t)(t0 + tt) * 4096 + 2 * b * 128 + r]); }
            if (tid < 32) { const int tt = tid >> 1, h = tid & 1; bb[tid] = BETA[(t0 + tt) * 32 + 2 * b + h]; gb[tid] = expf(GG[(t0 + tt) * 32 + 2 * b + h]); }
            __syncthreads();
            for (int tt = 0; tt < 16; ++tt) {
                const float* kk = kb + tt * 128 + half * 64; const float* qq = qb + tt * 128 + half * 64;
                const float eg = gb[tt * 2 + hl], be = bb[tt * 2 + hl], v = vb[tt * 256 + hl * 128 + col];
                float d0 = 0.f, d1 = 0.f, d2 = 0.f, d3 = 0.f;
#pragma unroll
                for (int k = 0; k < 64; k += 4) { if ((k & 15) == 0) asm volatile("" ::: "memory"); d0 += kk[k] * S[k]; d1 += kk[k + 1] * S[k + 1]; d2 += kk[k + 2] * S[k + 2]; d3 += kk[k + 3] * S[k + 3]; }
                float dd = (d0 + d1) + (d2 + d3); dd += __shfl_xor(dd, 1);
                const float vn = be * (v - eg * dd);
                float o0 = 0.f, o1 = 0.f, o2 = 0.f, o3 = 0.f;
#pragma unroll
                for (int k = 0; k < 64; k += 4) {
                    if ((k & 15) == 0) asm volatile("" ::: "memory");
                    S[k] = eg * S[k] + kk[k] * vn; o0 += qq[k] * S[k];
                    S[k + 1] = eg * S[k + 1] + kk[k + 1] * vn; o1 += qq[k + 1] * S[k + 1];
                    S[k + 2] = eg * S[k + 2] + kk[k + 2] * vn; o2 += qq[k + 2] * S[k + 2];
                    S[k + 3] = eg * S[k + 3] + kk[k + 3] * vn; o3 += qq[k + 3] * S[k + 3]; }
                float oo = (o0 + o1) + (o2 + o3); oo += __shfl_xor(oo, 1);
                if (half == 0) ORAW[(size_t)(t0 + tt) * 4096 + hv * 128 + col] = oo;
            }
        }
    }
    __syncthreads();
}
typedef float f32x16 __attribute__((ext_vector_type(16)));
DI int permpos(int a) { return ((a & 15) >> 2) * 8 + (a >> 4) * 4 + (a & 3); }
DI bf16_t bf1(float x) { return (bf16_t)(pk2(x, 0.f) & 0xffffu); }
DI void phase_gdn_prep(const Params& p, unsigned char* lds) { const int TIDX = ltid();
    const int tid = TIDX, wid = tid >> 6, lane = tid & 63;
    const bf16_t* raw = (const bf16_t*)(p.ws + O_QKVRAW); const float* ba = (const float*)(p.ws + O_BA);
    const float* sm = (const float*)(p.ws + O_SMALL); const float* cw = sm + S_CONV;
    float* Ks = (float*)lds;
    float* Qs = Ks + 64 * 132;
    float* KKs = Qs + 64 * 132;
    float* QKs = KKs + 64 * 65;
    float* gcs = QKs + 64 * 65;
    float* bts = gcs + 128;
    float* egs = bts + 128;
    bf16_t* Vs = (bf16_t*)(egs + 128);
    float* Am = Qs;
    for (int unit = blockIdx.x; unit < 2048; unit += gridDim.x) {
        const int hk = unit >> 7, n = unit & 127, t0 = n * 64;
        unsigned char* ohk = p.ws + O_PA_HK + (size_t)unit * 32768;
        __syncthreads();
        {
            unsigned xr[4][11]; f32x2 w[4][4];
#pragma unroll
            for (int itc = 0; itc < 4; ++itc) {
                const int cbase = (itc == 0) ? hk * 128 : (itc == 1) ? 2048 + hk * 128 : 4096 + (2 * hk + (itc - 2)) * 128;
                const int c = cbase + lane * 2, tb0 = t0 + wid * 8;
#pragma unroll
                for (int i = 0; i < 11; ++i) { const int tt = tb0 - 3 + i; xr[itc][i] = (tt >= 0) ? *(const unsigned*)(raw + (size_t)tt * 8192 + c) : 0u; }
#pragma unroll
                for (int j = 0; j < 4; ++j) w[itc][j] = *(const f32x2*)(cw + j * 8192 + c);
            }
#pragma unroll
            for (int itc = 0; itc < 4; ++itc) {
                float a0[8], a1[8];
#pragma unroll
                for (int i = 0; i < 8; ++i) { float s0 = 0.f, s1 = 0.f;
#pragma unroll
                    for (int j = 0; j < 4; ++j) { s0 += w[itc][j].x * bflo(xr[itc][i + j]); s1 += w[itc][j].y * bfhi(xr[itc][i + j]); }
                    a0[i] = silu_fast(s0); a1[i] = silu_fast(s1); }
                if (itc < 2) {
                    float ss[8];
#pragma unroll
                    for (int i = 0; i < 8; ++i) ss[i] = a0[i] * a0[i] + a1[i] * a1[i];
#pragma unroll
                    for (int d = 32; d >= 1; d >>= 1) {
#pragma unroll
                        for (int i = 0; i < 8; ++i) ss[i] += __shfl_xor(ss[i], d); }
                    float* dst = (itc == 0) ? Qs : Ks; const float sc = (itc == 0) ? 0.08838834764831845f : 1.0f;
#pragma unroll
                    for (int i = 0; i < 8; ++i) { const float r = sc / sqrtf(ss[i] + 1e-6f); f32x2 o; o.x = a0[i] * r; o.y = a1[i] * r; *(f32x2*)(dst + (wid * 8 + i) * 132 + lane * 2) = o; }
                } else {
#pragma unroll
                    for (int i = 0; i < 8; ++i) *(unsigned*)(Vs + (wid * 8 + i) * 256 + (itc - 2) * 128 + lane * 2) = pk2(a0[i], a1[i]);
                }
            }
        }
        if (wid < 2) { const int hv = 2 * hk + wid;
            const float av = ba[(size_t)(t0 + lane) * 64 + 32 + hv], bv = ba[(size_t)(t0 + lane) * 64 + hv];
            float s = -expf(sm[S_ALOG + hv]) * softplusf(av + sm[S_DTB + hv]);
#pragma unroll
            for (int d = 1; d < 64; d <<= 1) { const float o = __shfl_up(s, d); if (lane >= d) s += o; }
            gcs[wid * 64 + lane] = s; bts[wid * 64 + lane] = sigmf(bv); egs[wid * 64 + lane] = expf(s); }
        __syncthreads();
        {
            const float* X = (wid >> 2) ? Qs : Ks; const int ib = (wid >> 1) & 1, jb = wid & 1, r = lane & 31, h = lane >> 5;
            f32x16 acc;
#pragma unroll
            for (int i = 0; i < 16; ++i) acc[i] = 0.f;
            const float* ap = X + (ib * 32 + r) * 132; const float* bp = Ks + (jb * 32 + r) * 132;
#pragma unroll 8
            for (int u4 = 0; u4 < 32; ++u4) { const f32x4 a = *(const f32x4*)(ap + 4 * u4), b = *(const f32x4*)(bp + 4 * u4);
                acc = __builtin_amdgcn_mfma_f32_32x32x2f32(h ? a[1] : a[0], h ? b[1] : b[0], acc, 0, 0, 0);
                acc = __builtin_amdgcn_mfma_f32_32x32x2f32(h ? a[3] : a[2], h ? b[3] : b[2], acc, 0, 0, 0); }
            float* O = (wid >> 2) ? QKs : KKs;
#pragma unroll
            for (int i = 0; i < 16; ++i) O[(ib * 32 + (i & 3) + 8 * (i >> 2) + 4 * h) * 65 + jb * 32 + r] = acc[i];
        }
#pragma unroll 4
        for (int k = 0; k < 16; ++k) { const int idx = tid + 512 * k;
            { const int i = idx >> 7, dk = idx & 127, off = (dk & 96) + permpos(dk & 31);
              *(bf16_t*)(ohk + i * 256 + ((((off >> 3) ^ (i & 15))) << 4) + (off & 7) * 2) = bf1(Qs[i * 132 + dk]); }
            { const int dk = idx >> 6, tk = idx & 63, off = (tk & 32) + permpos(tk & 31);
              *(bf16_t*)(ohk + 16384 + dk * 128 + ((((off >> 3) ^ ((dk >> 1) & 7))) << 4) + (off & 7) * 2) = bf1(Ks[tk * 132 + dk]); } }
        __syncthreads();
#pragma unroll
        for (int r = 0; r < 2; ++r) { unsigned char* ohv = p.ws + O_PA_HV + (size_t)((2 * hk + r) * 128 + n) * 40960;
#pragma unroll 2
            for (int k = 0; k < 8; ++k) { const int idx = tid + 512 * k, i = idx >> 6, j = idx & 63;
                const float dec = __builtin_amdgcn_exp2f(1.4426950408889634f * (gcs[r * 64 + i] - gcs[r * 64 + j]));
                Am[r * 4096 + idx] = (j < i) ? bts[r * 64 + i] * KKs[i * 65 + j] * dec : 0.f;
                const float av = (j <= i) ? QKs[i * 65 + j] * dec : 0.f;
                const int off = (j & 32) + permpos(j & 31);
                *(bf16_t*)(ohv + 16384 + i * 128 + ((((off >> 3) ^ ((i >> 1) & 7))) << 4) + (off & 7) * 2) = bf1(av); } }
        if (tid < 128) { const int r = tid >> 6, i = tid & 63; float* G = (float*)(p.ws + O_PA_G) + (size_t)((2 * hk + r) * 128 + n) * 192;
            const float gi = gcs[r * 64 + i], gl = gcs[r * 64 + 63];
            G[i] = egs[r * 64 + i]; G[64 + i] = expf(gl - gi); if (i == 0) G[128] = expf(gl); }
        __syncthreads();
        {
            const int r = tid >> 8, c = tid & 255, hv = 2 * hk + r;
            unsigned char* ohv = p.ws + O_PA_HV + (size_t)(hv * 128 + n) * 40960;
            float sol[64];
            if (c < 128) {
#pragma unroll
                for (int i = 0; i < 64; ++i) sol[i] = bts[r * 64 + i] * bf2f(Vs[i * 256 + r * 128 + c]);
            } else {
#pragma unroll
                for (int i = 0; i < 64; ++i) sol[i] = bts[r * 64 + i] * egs[r * 64 + i] * Ks[i * 132 + (c - 128)];
            }
            __syncthreads();
            const float* ar = Am + r * 4096;
#pragma unroll
            for (int i = 1; i < 64; ++i) {
                float s0 = 0.f, s1 = 0.f, s2 = 0.f, s3 = 0.f;
#pragma unroll
                for (int j = 0; j < i; j += 4) { const f32x4 a = *(const f32x4*)(ar + i * 64 + j);
                    s0 += a[0] * sol[j]; s1 += a[1] * sol[j + 1]; s2 += a[2] * sol[j + 2]; s3 += a[3] * sol[j + 3]; }
                sol[i] -= (s0 + s1) + (s2 + s3);
            }
            if (c < 128) {
                bf16_t* U = (bf16_t*)(ohv + 24576); const int sl = c >> 4, l15 = c & 15;
#pragma unroll
                for (int mb = 0; mb < 4; ++mb)
#pragma unroll
                    for (int q = 0; q < 4; ++q) { const int i0 = mb * 16 + q * 4; u32x2 w; w.x = pk2(sol[i0], sol[i0 + 1]); w.y = pk2(sol[i0 + 2], sol[i0 + 3]);
                        *(u32x2*)(U + ((((sl * 4 + mb) * 4 + q) * 16 + l15) * 4)) = w; }
            } else {
                unsigned char* img = (unsigned char*)Ks + r * 16384;
                const int dk = c - 128, off = (dk & 96) + permpos(dk & 31), pc = off >> 3, eb = (off & 7) * 2;
#pragma unroll
                for (int i = 0; i < 64; ++i) *(bf16_t*)(img + i * 256 + ((pc ^ (i & 15)) << 4) + eb) = bf1(-sol[i]);
            }
        }
        __syncthreads();
#pragma unroll
        for (int k = 0; k < 4; ++k) { const int pi = tid + 512 * k, r = pi >> 10, pc = pi & 1023;
            *(u32x4*)(p.ws + O_PA_HV + (size_t)((2 * hk + r) * 128 + n) * 40960 + pc * 16) = *(const u32x4*)((const unsigned char*)Ks + r * 16384 + pc * 16); }
    }
    __syncthreads();
}

DI bf16x8 pack8(const f32x4& a, const f32x4& b) { u32x4 w; w.x = pk2(a[0], a[1]); w.y = pk2(a[2], a[3]); w.z = pk2(b[0], b[1]); w.w = pk2(b[2], b[3]); return __builtin_bit_cast(bf16x8, w); }
constexpr int SCAN_BUF = 66560;
DI void phase_gdn_scan(const Params& p, unsigned char* lds) { const int TIDX = ltid();
    const int tid = TIDX, wid = tid >> 6, lane = tid & 63, l15 = lane & 15, quad = lane >> 4;
    bf16_t* ORAW = (bf16_t*)(p.ws + O_ORAW);
    for (int item = blockIdx.x; item < 64; item += gridDim.x) {
        const int xcd_ = item & 7, slot_ = item >> 3, hk = xcd_ * 2 + (slot_ >> 2), hv = 2 * hk + ((slot_ >> 1) & 1), half = slot_ & 1;
        const unsigned char* hkb = p.ws + O_PA_HK + (size_t)(hk * 128) * 32768;
        const unsigned char* hvb = p.ws + O_PA_HV + (size_t)(hv * 128) * 40960;
        const unsigned char* gxb = p.ws + O_PA_G + (size_t)(hv * 128) * 768;
        __syncthreads();
        if (wid >= 4) {
            const int lt = tid - 256;
            u32x4 R0[17], R1[17];
#define SC_LD1(dst, ptr) asm volatile("global_load_dwordx4 %0, %1, off" : "=v"(dst) : "v"(ptr) : "memory")
#define SC_ST1(ptr, val) asm volatile("global_store_dwordx4 %0, %1, off\n\ts_nop 2" :: "v"(ptr), "v"(val) : "memory")
#define SC_LOAD(R, n_) do { const unsigned char* a_ = hvb + (size_t)(n_) * 40960 + lt * 16; const unsigned char* b_ = hkb + (size_t)(n_) * 32768 + lt * 16; \
                _Pragma("unroll") for (int k = 0; k < 4; ++k) SC_LD1(R[k], a_ + 4096 * k); \
                _Pragma("unroll") for (int k = 0; k < 4; ++k) SC_LD1(R[4 + k], b_ + 4096 * k); \
                _Pragma("unroll") for (int k = 0; k < 2; ++k) SC_LD1(R[8 + k], a_ + 16384 + 4096 * k); \
                _Pragma("unroll") for (int k = 0; k < 4; ++k) SC_LD1(R[10 + k], b_ + 16384 + 4096 * k); \
                _Pragma("unroll") for (int k = 0; k < 2; ++k) SC_LD1(R[14 + k], a_ + 24576 + half * 8192 + 4096 * k); \
                { const unsigned char* g_ = gxb + (size_t)(n_) * 768 + (lt < 48 ? lt : 47) * 16; SC_LD1(R[16], g_); } } while (0)
#define SC_WAIT(R, N) asm volatile("s_waitcnt vmcnt(" #N ")" : "+v"(R[0]), "+v"(R[1]), "+v"(R[2]), "+v"(R[3]), "+v"(R[4]), "+v"(R[5]), "+v"(R[6]), "+v"(R[7]), "+v"(R[8]), \
                "+v"(R[9]), "+v"(R[10]), "+v"(R[11]), "+v"(R[12]), "+v"(R[13]), "+v"(R[14]), "+v"(R[15]), "+v"(R[16]) :: "memory")
#define SC_WRITE(R, b_) do { unsigned char* d_ = lds + (b_) * SCAN_BUF; \
                _Pragma("unroll") for (int k = 0; k < 16; ++k) *(u32x4*)(d_ + (lt + 256 * k) * 16) = R[k]; \
                *(u32x4*)(d_ + 65536 + (lt < 48 ? lt : 47) * 16) = R[16]; } while (0)
#define SC_BAR_L() do { asm volatile("s_waitcnt lgkmcnt(0)" ::: "memory"); __builtin_amdgcn_s_barrier(); asm volatile("" ::: "memory"); } while (0)
#define SC_FLUSH(n_) do { const unsigned char* s_ = lds + 2 * SCAN_BUF + ((n_) & 1) * 8192; \
                _Pragma("unroll") for (int k = 0; k < 2; ++k) { const int pi = lt + 256 * k; const u32x4 w_ = *(const u32x4*)(s_ + pi * 16); \
                    bf16_t* o_ = ORAW + (size_t)((n_) * 64 + (pi >> 3)) * 4096 + hv * 128 + half * 64 + (pi & 7) * 8; SC_ST1(o_, w_); } } while (0)
            SC_LOAD(R0, 0); SC_WAIT(R0, 0); SC_WRITE(R0, 0); SC_LOAD(R1, 1);
            SC_FLUSH(0);
            SC_LOAD(R0, 2);
            SC_BAR_L();
            for (int n = 0; n < 128; n += 2) {
                SC_FLUSH(n > 0 ? n - 1 : 0);
                SC_WAIT(R1, 17); SC_WRITE(R1, 1); SC_LOAD(R1, (n + 3 < 128 ? n + 3 : 127));
                SC_BAR_L();
                SC_FLUSH(n);
                SC_WAIT(R0, 17); SC_WRITE(R0, 0); SC_LOAD(R0, (n + 4 < 128 ? n + 4 : 127));
                SC_BAR_L();
            }
            SC_FLUSH(127);
            asm volatile("s_waitcnt vmcnt(0)" ::: "memory");
#undef SC_FLUSH
#undef SC_LOAD
#undef SC_WRITE
#undef SC_BAR_L
#undef SC_WAIT
#undef SC_LD1
#undef SC_ST1
        } else {
            const int sl = half * 4 + wid;
            f32x4 Sacc[8];
#pragma unroll
            for (int i = 0; i < 8; ++i) Sacc[i] = (f32x4){0.f, 0.f, 0.f, 0.f};
            const int arow = l15 * 256, brow = l15 * 128, sw2 = l15 >> 1;
            asm volatile("" ::: "memory"); __builtin_amdgcn_s_barrier(); asm volatile("" ::: "memory");
            for (int n = 0; n < 128; ++n) {
                const unsigned char* Bb = lds + (n & 1) * SCAN_BUF;
                const unsigned char* Wl = Bb + arow; const unsigned char* Ql = Bb + 16384 + arow;
                const unsigned char* Al = Bb + 32768 + brow; const unsigned char* Kl = Bb + 40960 + brow;
                const unsigned char* Ul = Bb + 57344 + wid * 2048; const float* Gl = (const float*)(Bb + 65536);
                bf16x8 wf[16], qfr[16];
#pragma unroll
                for (int s = 0; s < 4; ++s) { const int po = ((4 * s + quad) ^ l15) << 4;
#pragma unroll
                    for (int mb = 0; mb < 4; ++mb) { wf[s * 4 + mb] = *(const bf16x8*)(Wl + mb * 4096 + po); qfr[s * 4 + mb] = *(const bf16x8*)(Ql + mb * 4096 + po); } }
                f32x4 vn[4], oacc[4];
#pragma unroll
                for (int mb = 0; mb < 4; ++mb) { const u32x2 uw = *(const u32x2*)(Ul + (((mb * 4 + quad) * 16 + l15) * 8));
                    vn[mb][0] = bflo(uw.x); vn[mb][1] = bfhi(uw.x); vn[mb][2] = bflo(uw.y); vn[mb][3] = bfhi(uw.y);
                    oacc[mb] = (f32x4){0.f, 0.f, 0.f, 0.f}; }
                bf16x8 Sf[4];
#pragma unroll
                for (int s = 0; s < 4; ++s) Sf[s] = pack8(Sacc[2 * s], Sacc[2 * s + 1]);
                __builtin_amdgcn_sched_barrier(0);
#pragma unroll
                for (int s = 0; s < 4; ++s)
#pragma unroll
                    for (int mb = 0; mb < 4; ++mb) vn[mb] = mfma16(wf[s * 4 + mb], Sf[s], vn[mb]);
                __builtin_amdgcn_sched_barrier(0);
                bf16x8 af[8], kf[16];
                const int po0 = ((0 + quad) ^ sw2) << 4, po1 = ((4 + quad) ^ sw2) << 4;
#pragma unroll
                for (int mb = 0; mb < 4; ++mb) { af[mb] = *(const bf16x8*)(Al + mb * 2048 + po0); af[4 + mb] = *(const bf16x8*)(Al + mb * 2048 + po1); }
                __builtin_amdgcn_sched_barrier(0);
#pragma unroll
                for (int s = 0; s < 4; ++s)
#pragma unroll
                    for (int mb = 0; mb < 4; ++mb) oacc[mb] = mfma16(qfr[s * 4 + mb], Sf[s], oacc[mb]);
                __builtin_amdgcn_sched_barrier(0);
#pragma unroll
                for (int m8 = 0; m8 < 8; ++m8) { kf[m8] = *(const bf16x8*)(Kl + m8 * 2048 + po0); kf[8 + m8] = *(const bf16x8*)(Kl + m8 * 2048 + po1); }
                f32x4 egv[4], eglv[4];
#pragma unroll
                for (int mb = 0; mb < 4; ++mb) { egv[mb] = *(const f32x4*)(Gl + mb * 16 + quad * 4); eglv[mb] = *(const f32x4*)(Gl + 64 + mb * 16 + quad * 4); }
                const float egl = Gl[128];
                bf16x8 vf[2];
#pragma unroll
                for (int s2 = 0; s2 < 2; ++s2) vf[s2] = pack8(vn[2 * s2], vn[2 * s2 + 1]);
#pragma unroll
                for (int mb = 0; mb < 4; ++mb) oacc[mb] *= egv[mb];
                __builtin_amdgcn_sched_barrier(0);
#pragma unroll
                for (int s2 = 0; s2 < 2; ++s2)
#pragma unroll
                    for (int mb = 0; mb < 4; ++mb) oacc[mb] = mfma16(af[s2 * 4 + mb], vf[s2], oacc[mb]);
#pragma unroll
                for (int mb = 0; mb < 4; ++mb) vn[mb] *= eglv[mb];
#pragma unroll
                for (int s2 = 0; s2 < 2; ++s2) vf[s2] = pack8(vn[2 * s2], vn[2 * s2 + 1]);
#pragma unroll
                for (int i = 0; i < 8; ++i) Sacc[i] *= egl;
                __builtin_amdgcn_sched_barrier(0);
#pragma unroll
                for (int s2 = 0; s2 < 2; ++s2)
#pragma unroll
                    for (int m8 = 0; m8 < 8; ++m8) Sacc[m8] = mfma16(kf[s2 * 8 + m8], vf[s2], Sacc[m8]);
                {   bf16_t* op = (bf16_t*)(lds + 2 * SCAN_BUF + (n & 1) * 8192) + (quad * 4) * 64 + wid * 16 + l15;
#pragma unroll
                    for (int mb = 0; mb < 4; ++mb) { const unsigned w01 = pk2(oacc[mb][0], oacc[mb][1]), w23 = pk2(oacc[mb][2], oacc[mb][3]);
                        op[(mb * 16 + 0) * 64] = (bf16_t)(w01 & 0xffffu); op[(mb * 16 + 1) * 64] = (bf16_t)(w01 >> 16);
                        op[(mb * 16 + 2) * 64] = (bf16_t)(w23 & 0xffffu); op[(mb * 16 + 3) * 64] = (bf16_t)(w23 >> 16); } }
                asm volatile("s_waitcnt lgkmcnt(0)" ::: "memory"); __builtin_amdgcn_s_barrier(); asm volatile("" ::: "memory");
            }
        }
    }
    __syncthreads();
}

DI void phase_gdn_gate(const Params& p) { const int TIDX = ltid();
    const bf16_t* ORAW = (const bf16_t*)(p.ws + O_ORAW); const bf16_t* Z = (const bf16_t*)(p.ws + O_Z); bf16_t* OG = (bf16_t*)(p.ws + O_OG);
    const int wid = TIDX >> 6, lane = TIDX & 63;
    const f32x2 nw = *(const f32x2*)((const float*)(p.ws + O_SMALL) + S_GNORM + lane * 2);
    const int step = gridDim.x * 8, nb = L_ * 32 / 8;
    int it4 = blockIdx.x * 8 + wid;
    unsigned ow[8], zw[8], own[8], zwn[8];
    if (it4 < nb) {
#pragma unroll
        for (int i = 0; i < 8; ++i) { const size_t off = (size_t)(it4 * 8 + i) * 128 + lane * 2; ow[i] = *(const unsigned*)(ORAW + off); zw[i] = *(const unsigned*)(Z + off); }
    }
    for (; it4 < nb; it4 += step) {
        const int nx = (it4 + step < nb) ? it4 + step : it4;
#pragma unroll
        for (int i = 0; i < 8; ++i) { const size_t off = (size_t)(nx * 8 + i) * 128 + lane * 2; own[i] = *(const unsigned*)(ORAW + off); zwn[i] = *(const unsigned*)(Z + off); }
        float ss[8];
#pragma unroll
        for (int i = 0; i < 8; ++i) ss[i] = bflo(ow[i]) * bflo(ow[i]) + bfhi(ow[i]) * bfhi(ow[i]);
#pragma unroll
        for (int d = 32; d >= 1; d >>= 1) {
#pragma unroll
            for (int i = 0; i < 8; ++i) ss[i] += __shfl_xor(ss[i], d); }
#pragma unroll
        for (int i = 0; i < 8; ++i) { const size_t off = (size_t)(it4 * 8 + i) * 128 + lane * 2;
            const float rstd = 1.0f / sqrtf(ss[i] * (1.0f / 128.0f) + 1e-6f);
            *(unsigned*)(OG + off) = pk2(bflo(ow[i]) * rstd * nw.x * silu_fast(bflo(zw[i])), bfhi(ow[i]) * rstd * nw.y * silu_fast(bfhi(zw[i]))); }
#pragma unroll
        for (int i = 0; i < 8; ++i) { ow[i] = own[i]; zw[i] = zwn[i]; }
    }
}

DI void phase_kvpost(const Params& p) { const int TIDX = ltid();
    const float* kv = (const float*)(p.ws + O_KVRAW);
    bf16_t* KB = (bf16_t*)(p.ws + O_KB); bf16_t* VB = (bf16_t*)(p.ws + O_VB); float* FC = (float*)(p.ws + O_FCUM);
    const int wid = TIDX >> 6, lane = TIDX & 63;
    const int gw = blockIdx.x * 8 + wid, nw = gridDim.x * 8;
    if (gw < 16) {
        const int h = gw; const float fb = ((const float*)(p.ws + O_SMALL))[S_FB + h];
        double carry = 0.0;
        for (int t0 = 0; t0 < L_; t0 += 64) {
            const float xl = kv[(size_t)(t0 + lane) * 1280 + 1024 + h] + fb;
            double s = (double)(-softplusf(-xl));
#pragma unroll
            for (int d = 1; d < 64; d <<= 1) { const double o = __shfl_up(s, d); if (lane >= d) s += o; }
            FC[(size_t)(t0 + lane) * 16 + h] = (float)(carry + s);
            carry += __shfl(s, 63);
        }
    }
    for (int t = gw; t < L_; t += nw) {
        const float* r = kv + (size_t)t * 1280;
#pragma unroll
        for (int hd = 0; hd < 2; ++hd) {
            const f32x4 k = *(const f32x4*)(r + hd * 256 + lane * 4);
            const float ss = wave_sum(k[0] * k[0] + k[1] * k[1] + k[2] * k[2] + k[3] * k[3]);
            const float rstd = 1.0f / sqrtf(ss * (1.0f / 256.0f) + 1e-6f);
            const f32x4 w = *(const f32x4*)((const float*)(p.ws + O_SMALL) + S_KNORM + lane * 4);
            u32x2 o; o.x = pk2(k[0] * rstd * w[0], k[1] * rstd * w[1]); o.y = pk2(k[2] * rstd * w[2], k[3] * rstd * w[3]);
            *(u32x2*)(KB + (size_t)t * 512 + hd * 256 + lane * 4) = o;
            const f32x4 v = *(const f32x4*)(r + 512 + hd * 256 + lane * 4);
            u32x2 ov; ov.x = pk2(v[0], v[1]); ov.y = pk2(v[2], v[3]);
            *(u32x2*)(VB + (size_t)t * 512 + hd * 256 + lane * 4) = ov;
        }
    }
}

DI void phase_attn_naive(const Params& p, unsigned char* lds) { const int TIDX = ltid();
    const bf16_t* QRAW = (const bf16_t*)(p.ws + O_QRAW); const bf16_t* GS = (const bf16_t*)(p.ws + O_GSIG);
    const bf16_t* KB = (const bf16_t*)(p.ws + O_KB); const bf16_t* VB = (const bf16_t*)(p.ws + O_VB); const float* FC = (const float*)(p.ws + O_FCUM);
    bf16_t* OG = (bf16_t*)(p.ws + O_OG2);
    const int wid = TIDX >> 6, lane = TIDX & 63;
    float* qs = (float*)lds + wid * 256;
    for (int item = blockIdx.x * 8 + wid; item < L_ * 16; item += gridDim.x * 8) {
        const int t = L_ - 1 - (item >> 4), h = item & 15, kvh = h >> 3;
        const u32x2 qw = *(const u32x2*)(QRAW + (size_t)t * 4096 + h * 256 + lane * 4);
        float q0 = bflo(qw.x), q1 = bfhi(qw.x), q2 = bflo(qw.y), q3 = bfhi(qw.y);
        const float ss = wave_sum(q0 * q0 + q1 * q1 + q2 * q2 + q3 * q3);
        const float rs = (1.0f / sqrtf(ss * (1.0f / 256.0f) + 1e-6f)) * 0.0625f;
        const f32x4 qn = *(const f32x4*)((const float*)(p.ws + O_SMALL) + S_QNORM + lane * 4);
        __builtin_amdgcn_wave_barrier();
        f32x4 qv; qv[0] = q0 * rs * qn[0]; qv[1] = q1 * rs * qn[1]; qv[2] = q2 * rs * qn[2]; qv[3] = q3 * rs * qn[3];
        *(f32x4*)(qs + lane * 4) = qv;
        __builtin_amdgcn_wave_barrier();
        const float Ft = FC[(size_t)t * 16 + h];
        float m = -INFINITY, l = 0.f, O0 = 0.f, O1 = 0.f, O2 = 0.f, O3 = 0.f;
        for (int s0 = 0; s0 <= t; s0 += 64) {
            const int s = s0 + lane; const bool valid = s <= t;
            float dot = 0.f;
            if (valid) {
                const u32x4* kr = (const u32x4*)(KB + ((size_t)s * 2 + kvh) * 256);
#pragma unroll 4
                for (int c = 0; c < 32; ++c) { const u32x4 kw = kr[c]; const f32x4 qa = *(const f32x4*)(qs + c * 8), qb = *(const f32x4*)(qs + c * 8 + 4);
                    dot += qa[0] * bflo(kw.x) + qa[1] * bfhi(kw.x) + qa[2] * bflo(kw.y) + qa[3] * bfhi(kw.y)
                         + qb[0] * bflo(kw.z) + qb[1] * bfhi(kw.z) + qb[2] * bflo(kw.w) + qb[3] * bfhi(kw.w); }
            }
            const float sc = valid ? dot + (Ft - FC[(size_t)s * 16 + h]) : -INFINITY;
            const float mn = fmaxf(m, wave_max(sc));
            const float alpha = expf(m - mn);
            const float pr = valid ? expf(sc - mn) : 0.f;
            l = l * alpha + wave_sum(pr);
            O0 *= alpha; O1 *= alpha; O2 *= alpha; O3 *= alpha;
            const int nk = min(64, t - s0 + 1);
            for (int j = 0; j < nk; ++j) {
                const float pj = __shfl(pr, j);
                const u32x2 vw = *(const u32x2*)(VB + ((size_t)(s0 + j) * 2 + kvh) * 256 + lane * 4);
                O0 += pj * bflo(vw.x); O1 += pj * bfhi(vw.x); O2 += pj * bflo(vw.y); O3 += pj * bfhi(vw.y);
            }
            m = mn;
        }
        const float il = 1.0f / l;
        const u32x2 gw2 = *(const u32x2*)(GS + (size_t)t * 4096 + h * 256 + lane * 4);
        u32x2 o; o.x = pk2(O0 * il * bflo(gw2.x), O1 * il * bfhi(gw2.x)); o.y = pk2(O2 * il * bflo(gw2.y), O3 * il * bfhi(gw2.y));
        *(u32x2*)(OG + (size_t)t * 4096 + h * 256 + lane * 4) = o;
    }
    __syncthreads();
}

DI void phase_kvpost2(const Params& p, unsigned char* lds) { const int TIDX = ltid();
    const float* kv = (const float*)(p.ws + O_KVRAW); const float* sm = (const float*)(p.ws + O_SMALL);
    bf16_t* KB = (bf16_t*)(p.ws + O_KB); bf16_t* VT = (bf16_t*)(p.ws + O_VB); float* FCT = (float*)(p.ws + O_FCUM); bf16_t* Q = (bf16_t*)(p.ws + O_QRAW);
    const int wid = TIDX >> 6, lane = TIDX & 63;
    const int gw = blockIdx.x * 8 + wid, nw = gridDim.x * 8;
    for (int h = blockIdx.x; h < 16; h += gridDim.x) {
        double* wtot = (double*)lds;
        const float fb = sm[S_FB + h];
        float xs[16];
#pragma unroll
        for (int it = 0; it < 16; ++it) xs[it] = kv[(size_t)(wid * 1024 + it * 64 + lane) * 1280 + 1024 + h];
        double vals[16]; double run = 0.0;
#pragma unroll
        for (int it = 0; it < 16; ++it) {
            double s = (double)(-softplusf(-(xs[it] + fb)));
#pragma unroll
            for (int d = 1; d < 64; d <<= 1) { const double o = __shfl_up(s, d); if (lane >= d) s += o; }
            vals[it] = run + s; run += __shfl(s, 63);
        }
        __syncthreads();
        if (lane == 0) wtot[wid] = run;
        __syncthreads();
        double off = 0.0;
#pragma unroll
        for (int w = 0; w < 8; ++w) off += (w < wid) ? wtot[w] : 0.0;
#pragma unroll
        for (int it = 0; it < 16; ++it) FCT[(size_t)h * L_ + wid * 1024 + it * 64 + lane] = (float)((off + vals[it]) * 1.4426950408889634);
        __syncthreads();
    }
    {
        const f32x4 qn = *(const f32x4*)(sm + S_QNORM + lane * 4);
        for (int it8 = gw; it8 < L_ * 16 / 8; it8 += nw) {
            u32x2 qw[8]; float ss[8];
#pragma unroll
            for (int i = 0; i < 8; ++i) qw[i] = *(const u32x2*)(Q + (size_t)(it8 * 8 + i) * 256 + lane * 4);
#pragma unroll
            for (int i = 0; i < 8; ++i) { const float q0 = bflo(qw[i].x), q1 = bfhi(qw[i].x), q2 = bflo(qw[i].y), q3 = bfhi(qw[i].y); ss[i] = q0 * q0 + q1 * q1 + q2 * q2 + q3 * q3; }
#pragma unroll
            for (int d = 32; d >= 1; d >>= 1) {
#pragma unroll
                for (int i = 0; i < 8; ++i) ss[i] += __shfl_xor(ss[i], d); }
#pragma unroll
            for (int i = 0; i < 8; ++i) { const float rs = (1.0f / sqrtf(ss[i] * (1.0f / 256.0f) + 1e-6f)) * (0.0625f * 1.4426950408889634f);
                u32x2 o; o.x = pk2(bflo(qw[i].x) * rs * qn[0], bfhi(qw[i].x) * rs * qn[1]); o.y = pk2(bflo(qw[i].y) * rs * qn[2], bfhi(qw[i].y) * rs * qn[3]);
                *(u32x2*)(Q + (size_t)(it8 * 8 + i) * 256 + lane * 4) = o; }
        }
    }
    bf16_t* vt = (bf16_t*)lds;
    const f32x4 kw = *(const f32x4*)(sm + S_KNORM + lane * 4);
    for (int blk = blockIdx.x; blk < 128; blk += gridDim.x) {
        __syncthreads();
        for (int rr = wid; rr < 64; rr += 8) {
            const int t = blk * 64 + rr;
            const float* r = kv + (size_t)t * 1280;
#pragma unroll
            for (int hd = 0; hd < 2; ++hd) {
                const f32x4 k = *(const f32x4*)(r + hd * 256 + lane * 4);
                const float ss = wave_sum(k[0] * k[0] + k[1] * k[1] + k[2] * k[2] + k[3] * k[3]);
                const float rstd = 1.0f / sqrtf(ss * (1.0f / 256.0f) + 1e-6f);
                u32x2 o; o.x = pk2(k[0] * rstd * kw[0], k[1] * rstd * kw[1]); o.y = pk2(k[2] * rstd * kw[2], k[3] * rstd * kw[3]);
                *(u32x2*)(KB + (size_t)t * 512 + hd * 256 + lane * 4) = o;
                const f32x4 v = *(const f32x4*)(r + 512 + hd * 256 + lane * 4);
                const unsigned v01 = pk2(v[0], v[1]), v23 = pk2(v[2], v[3]);
                bf16_t* vp = vt + (hd * 256 + lane * 4) * 72 + ((rr & 32) + permpos(rr & 31));
                vp[0] = (bf16_t)(v01 & 0xffffu); vp[72] = (bf16_t)(v01 >> 16); vp[144] = (bf16_t)(v23 & 0xffffu); vp[216] = (bf16_t)(v23 >> 16);
            }
        }
        __syncthreads();
#pragma unroll
        for (int i = 0; i < 8; ++i) { const int pi = TIDX + 512 * i, d = pi >> 3, c = pi & 7;
            const u32x4 w = *(const u32x4*)(vt + d * 72 + c * 8);
            *(u32x4*)(VT + (size_t)d * L_ + blk * 64 + c * 8) = w; }
    }
    __syncthreads();
}

DI void phase_attn(const Params& p, unsigned char* lds) { const int TIDX = ltid();
    const bf16_t* QN = (const bf16_t*)(p.ws + O_QRAW); const bf16_t* GS = (const bf16_t*)(p.ws + O_GSIG);
    const bf16_t* KB = (const bf16_t*)(p.ws + O_KB); const bf16_t* VT = (const bf16_t*)(p.ws + O_VB); const float* FCT = (const float*)(p.ws + O_FCUM);
    bf16_t* OG = (bf16_t*)(p.ws + O_OG2);
    const int tid = TIDX, wid = __builtin_amdgcn_readfirstlane(tid >> 6), lane = tid & 63, l15 = lane & 15, quad = lane >> 4;
    const float LOG2E = 1.4426950408889634f;
    float kmax;
    { const f32x4 kw = *(const f32x4*)((const float*)(p.ws + O_SMALL) + S_KNORM + lane * 4);
      kmax = wave_max(fmaxf(fmaxf(fabsf(kw[0]), fabsf(kw[1])), fmaxf(fabsf(kw[2]), fabsf(kw[3])))) * 16.0f * 1.01f; }
    unsigned kofs0, vofs0;
    { const int r = 2 * wid + (lane >> 5), c = (lane & 31) ^ (r & 15); kofs0 = (unsigned)((r * 512 + c * 8) * 2); }
    { const int r = 8 * wid + (lane >> 3), c = (lane & 7) ^ ((r >> 1) & 7); vofs0 = (unsigned)((r * L_ + c * 8) * 2); }
    for (int si = blockIdx.x; si < 256; si += gridDim.x) {
        const int xcd = si & 7, slot = si >> 3, kvh = xcd & 1, cidx = (xcd >> 1) * 32 + slot, h = kvh * 8 + (cidx & 7), jj = cidx >> 3;
        const bf16_t* Kg = KB + kvh * 256;
        const bf16_t* Vg = VT + (size_t)kvh * 256 * L_;
        const float* Fh = FCT + (size_t)h * L_;
        for (int it = 0; it < 4; ++it) {
            const int qb = (it == 0) ? 63 - jj : (it == 1) ? 32 + jj : (it == 2) ? 31 - jj : jj;
            const int q0 = qb * 128, ntile = 2 * qb + 2;
            const int qrow = q0 + wid * 16 + l15;
            bf16x8 qf[8];
#pragma unroll
            for (int s = 0; s < 8; ++s) qf[s] = *(const bf16x8*)(QN + (size_t)qrow * 4096 + h * 256 + s * 32 + quad * 8);
            float qss = 0.f;
#pragma unroll
            for (int s = 0; s < 8; ++s) { const u32x4 qw = __builtin_bit_cast(u32x4, qf[s]);
                qss += bflo(qw.x) * bflo(qw.x) + bfhi(qw.x) * bfhi(qw.x) + bflo(qw.y) * bflo(qw.y) + bfhi(qw.y) * bfhi(qw.y)
                     + bflo(qw.z) * bflo(qw.z) + bfhi(qw.z) * bfhi(qw.z) + bflo(qw.w) * bflo(qw.w) + bfhi(qw.w) * bfhi(qw.w); }
            qss += __shfl_xor(qss, 16); qss += __shfl_xor(qss, 32);
            const float Mrow = sqrtf(qss) * kmax;
            const float Ft = Fh[qrow] - Mrow;
            f32x4 oacc[16];
#pragma unroll
            for (int d = 0; d < 16; ++d) oacc[d] = (f32x4){0.f, 0.f, 0.f, 0.f};
            float lrun = 0.f;
#define ATT_DMA(kt_, b_) do { const char* kb_ = (const char*)Kg + (size_t)(kt_) * 65536; const char* vb_ = (const char*)Vg + (size_t)(kt_) * 128; \
                PG8_LAS unsigned char* L_ = (PG8_LAS unsigned char*)lds + (b_) * 65536 + wid * 1024; \
                _Pragma("unroll") for (int i = 0; i < 4; ++i) { \
                    __builtin_amdgcn_global_load_lds((const unsigned*)(kb_ + (size_t)i * 16384 + kofs0), (PG8_LAS unsigned*)(L_ + i * 8192), 16, 0, 0); \
                    __builtin_amdgcn_global_load_lds((const unsigned*)(vb_ + (size_t)i * 1048576 + vofs0), (PG8_LAS unsigned*)(L_ + 32768 + i * 8192), 16, 0, 0); } \
                if (wid == 0) __builtin_amdgcn_global_load_lds((const unsigned*)(Fh + 64 * (kt_) + lane), (PG8_LAS unsigned*)((PG8_LAS unsigned char*)lds + 131072 + (b_) * 256), 4, 0, 0); } while (0)
#define ATT_DMA1(kt_, b_, i_) do { const char* kb_ = (const char*)Kg + (size_t)(kt_) * 65536; const char* vb_ = (const char*)Vg + (size_t)(kt_) * 128; \
                PG8_LAS unsigned char* L_ = (PG8_LAS unsigned char*)lds + (b_) * 65536 + wid * 1024; \
                __builtin_amdgcn_global_load_lds((const unsigned*)(kb_ + (size_t)(i_) * 16384 + kofs0), (PG8_LAS unsigned*)(L_ + (i_) * 8192), 16, 0, 0); \
                __builtin_amdgcn_global_load_lds((const unsigned*)(vb_ + (size_t)(i_) * 1048576 + vofs0), (PG8_LAS unsigned*)(L_ + 32768 + (i_) * 8192), 16, 0, 0); \
                if ((i_) == 3 && wid == 0) __builtin_amdgcn_global_load_lds((const unsigned*)(Fh + 64 * (kt_) + lane), (PG8_LAS unsigned*)((PG8_LAS unsigned char*)lds + 131072 + (b_) * 256), 4, 0, 0); } while (0)
            ATT_DMA(0, 0);
            asm volatile("s_waitcnt vmcnt(0)" ::: "memory");
            __syncthreads();
            for (int kt = 0; kt < ntile; ++kt) {
                const int b = kt & 1;
                const bool more = (kt + 1 < ntile);
                const int wq0 = q0 + wid * 16;
                const bool compute = (64 * kt <= wq0 + 15);
                if (more && (!compute || wid < 4)) ATT_DMA(kt + 1, b ^ 1);
                if (compute) {
                    const unsigned char* Kb = lds + b * 65536; const unsigned char* Vb = Kb + 32768;
                    const float* Fl = (const float*)(lds + 131072 + b * 256);
                    f32x4 sacc[4];
#pragma unroll
                    for (int kb = 0; kb < 4; ++kb) { const f32x4 fs = *(const f32x4*)(Fl + kb * 16 + quad * 4); sacc[kb] = Ft - fs; }
                    const unsigned char* kp0 = Kb + l15 * 512;
                    bf16x8 kfA[4], kfB[4];
#pragma unroll
                    for (int kb = 0; kb < 4; ++kb) kfA[kb] = *(const bf16x8*)(kp0 + (((0 + quad) ^ l15) * 16) + kb * 8192);
#pragma unroll
                    for (int s = 0; s < 8; s += 2) {
#pragma unroll
                        for (int kb = 0; kb < 4; ++kb) kfB[kb] = *(const bf16x8*)(kp0 + (((4 * (s + 1) + quad) ^ l15) * 16) + kb * 8192);
#pragma unroll
                        for (int kb = 0; kb < 4; ++kb) sacc[kb] = mfma16(kfA[kb], qf[s], sacc[kb]);
                        asm volatile("" ::: "memory");
                        if (s + 2 < 8) {
#pragma unroll
                            for (int kb = 0; kb < 4; ++kb) kfA[kb] = *(const bf16x8*)(kp0 + (((4 * (s + 2) + quad) ^ l15) * 16) + kb * 8192); }
#pragma unroll
                        for (int kb = 0; kb < 4; ++kb) sacc[kb] = mfma16(kfB[kb], qf[s + 1], sacc[kb]);
                        asm volatile("" ::: "memory");
                    }
                    if (more && wid >= 4) ATT_DMA(kt + 1, b ^ 1);
                    const bool domask = (64 * kt + 63 > wq0);
                    float psum = 0.f;
#pragma unroll
                    for (int kb = 0; kb < 4; ++kb) {
                        const int key0 = 64 * kt + kb * 16 + quad * 4;
#pragma unroll
                        for (int j = 0; j < 4; ++j) { float v = sacc[kb][j];
                            if (domask && (key0 + j > qrow)) v = -INFINITY;
                            const float pv = __builtin_amdgcn_exp2f(v); psum += pv; sacc[kb][j] = pv; } }
                    lrun += psum;
                    const int sw = l15 >> 1;
#pragma unroll
                    for (int s2 = 0; s2 < 2; ++s2) {
                        const bf16x8 pf = pack8(sacc[2 * s2], sacc[2 * s2 + 1]);
                        const unsigned char* pv_ = Vb + l15 * 128 + (((4 * s2 + quad) ^ sw) * 16);
                        bf16x8 vA[4], vB[4];
#pragma unroll
                        for (int e = 0; e < 4; ++e) vA[e] = *(const bf16x8*)(pv_ + e * 2048);
#pragma unroll
                        for (int d8 = 0; d8 < 16; d8 += 8) {
#pragma unroll
                            for (int e = 0; e < 4; ++e) vB[e] = *(const bf16x8*)(pv_ + (d8 + 4 + e) * 2048);
#pragma unroll
                            for (int e = 0; e < 4; ++e) oacc[d8 + e] = mfma16(vA[e], pf, oacc[d8 + e]);
                            asm volatile("" ::: "memory");
                            if (d8 + 8 < 16) {
#pragma unroll
                                for (int e = 0; e < 4; ++e) vA[e] = *(const bf16x8*)(pv_ + (d8 + 8 + e) * 2048); }
#pragma unroll
                            for (int e = 0; e < 4; ++e) oacc[d8 + 4 + e] = mfma16(vB[e], pf, oacc[d8 + 4 + e]);
                            asm volatile("" ::: "memory");
                        }
                    }
                }
                asm volatile("s_waitcnt vmcnt(0)" ::: "memory");
                __syncthreads();
            }
#undef ATT_DMA
#undef ATT_DMA1
            float lt = lrun; lt += __shfl_xor(lt, 16); lt += __shfl_xor(lt, 32);
            const float il = 1.0f / lt;
#pragma unroll
            for (int d = 0; d < 16; ++d) {
                const size_t off = (size_t)qrow * 4096 + h * 256 + d * 16 + quad * 4;
                const u32x2 g = *(const u32x2*)(GS + off);
                u32x2 o; o.x = pk2(oacc[d][0] * il * bflo(g.x), oacc[d][1] * il * bfhi(g.x)); o.y = pk2(oacc[d][2] * il * bflo(g.y), oacc[d][3] * il * bfhi(g.y));
                *(u32x2*)(OG + off) = o; }
        }
    }
    __syncthreads();
}

constexpr int NPHASE = 21;
template <int PH>
DI void run_phase(const Params& p, unsigned char* lds) {
    unsigned char* ws = p.ws;
    const float* mod = (const float*)(ws + O_MOD);
    float* XS = (float*)(ws + O_XS);
    bf16_t* H = (bf16_t*)(ws + O_H); bf16_t* H2 = (bf16_t*)(ws + O_H2);
    const float* sm = (const float*)(ws + O_SMALL);
    if constexpr (PH == 0) { phase_copysmall(p); phase_adaln(p, lds, (int)blockIdx.x, (int)gridDim.x, 0, 24); phase_convert(p, lds, (int)blockIdx.x, (int)gridDim.x, 0, 2); }
    else if constexpr (PH == 1) { phase_modreduce(p, 0, 12288); }
    else if constexpr (PH == 2) { phase_normmod(p.x, sm + S_NORM_MIX, mod + 0, mod + 2048, H, nullptr, nullptr, nullptr, nullptr); }
    else if constexpr (PH == 3) { EpiGdnIn E{(bf16_t*)(ws + O_QKVRAW), (bf16_t*)(ws + O_Z), (float*)(ws + O_BA)}; run_gemm(lds, H, (const bf16_t*)(ws + O_WGIN), 12544, 2048, E); }
    else if constexpr (PH == 4) {   }
    else if constexpr (PH == 5) { phase_gdn_prep(p, lds); }
    else if constexpr (PH == 6) {
        if (blockIdx.x < 64 || gridDim.x <= 64) phase_gdn_scan(p, lds);
        if (gridDim.x <= 64) { phase_adaln(p, lds, (int)blockIdx.x, (int)gridDim.x, 24, 40); phase_convert(p, lds, (int)blockIdx.x, (int)gridDim.x, 2, 9); }
        else if (blockIdx.x >= 64) { phase_adaln(p, lds, (int)blockIdx.x - 64, (int)gridDim.x - 64, 24, 40); phase_convert(p, lds, (int)blockIdx.x - 64, (int)gridDim.x - 64, 2, 9); }
    }
    else if constexpr (PH == 7) { phase_gdn_gate(p); phase_modreduce(p, 12288, 32768); }
    else if constexpr (PH == 8) { EpiResid E{p.x, XS, mod + 2 * 2048}; run_gemm(lds, (const bf16_t*)(ws + O_OG), (const bf16_t*)(ws + O_WGOUT), 2048, 4096, E); }
    else if constexpr (PH == 9) { phase_normmod(XS, sm + S_NORM_FFN, mod + 3 * 2048, mod + 4 * 2048, H, nullptr, nullptr, nullptr, nullptr); }
    else if constexpr (PH == 10) { EpiSwiglu E{(bf16_t*)(ws + O_HID)}; run_gemm(lds, H, (const bf16_t*)(ws + O_WFIN), 11264, 2048, E); }
    else if constexpr (PH == 11) { EpiResid E{XS, XS, mod + 5 * 2048}; run_gemm(lds, (const bf16_t*)(ws + O_HID), (const bf16_t*)(ws + O_WFOUT), 2048, 5632, E); }
    else if constexpr (PH == 12) { phase_normmod(XS, sm + S_NORM_MIX + 2048, mod + 12288, mod + 12288 + 2048, H, sm + S_KVNORM, mod + 24576, mod + 24576 + 2048, H2); }
    else if constexpr (PH == 13) {
        { EpiFoxIn E{(bf16_t*)(ws + O_QRAW), (bf16_t*)(ws + O_GSIG)}; run_gemm(lds, H, (const bf16_t*)(ws + O_WXIN), 8192, 2048, E); }
        { EpiKV E{(float*)(ws + O_KVRAW)}; run_gemm(lds, H2, (const bf16_t*)(ws + O_WKV), 1280, 2048, E); }
    }
    else if constexpr (PH == 14) { phase_kvpost2(p, lds); }
    else if constexpr (PH == 15) { phase_attn(p, lds); }
    else if constexpr (PH == 16) { EpiResid E{XS, XS, mod + 12288 + 2 * 2048}; run_gemm(lds, (const bf16_t*)(ws + O_OG2), (const bf16_t*)(ws + O_WXOUT), 2048, 4096, E); }
    else if constexpr (PH == 17) { phase_normmod(XS, sm + S_NORM_FFN + 2048, mod + 12288 + 3 * 2048, mod + 12288 + 4 * 2048, H, nullptr, nullptr, nullptr, nullptr); }
    else if constexpr (PH == 18) { EpiSwiglu E{(bf16_t*)(ws + O_HID)}; run_gemm(lds, H, (const bf16_t*)(ws + O_WFIN + SZ_WFIN), 11264, 2048, E); }
    else if constexpr (PH == 19) { EpiResid E{XS, XS, mod + 12288 + 5 * 2048}; run_gemm(lds, (const bf16_t*)(ws + O_HID), (const bf16_t*)(ws + O_WFOUT + SZ_WFOUT), 2048, 5632, E); }
    else if constexpr (PH == 20) { phase_final(XS, sm + S_ONORM, mod + 28672, mod + 28672 + 2048, p.out); }
}

#ifndef MEGA
#define MEGA 1
#endif

#if MEGA
#ifndef EXTRASYNC
#define EXTRASYNC 0
#endif
#ifndef REPMASK
#define REPMASK 0
#endif
#ifndef PHMASK
#define PHMASK 0x1FFFFF
#endif
#define LAS __attribute__((address_space(3)))
#define XB_TMO      128
#define XB_XCNT(j)  (256  + 64 * (j))
#define XB_XSUB(j)  (1280 + 64 * (j))
#define XB_XGEN(j)  (2304 + 64 * (j))
#define XB_TOP      3328
#define XB_TOPGEN   3392
#define XCD_BAR_WORDS 3456
#define XB_SPIN_CAP (1u << 18)

__device__ __forceinline__ unsigned xb_ld(unsigned* p)              { return __hip_atomic_load(p, __ATOMIC_RELAXED, __HIP_MEMORY_SCOPE_AGENT); }
__device__ __forceinline__ unsigned xb_add(unsigned* p, unsigned v) { return __hip_atomic_fetch_add(p, v, __ATOMIC_RELAXED, __HIP_MEMORY_SCOPE_AGENT); }
__device__ __forceinline__ unsigned xb_xcc_id() { return (unsigned)__builtin_amdgcn_s_getreg((3 << 11) | 20) & 0xFu; }
#define XB_SPIN(cond, bar) do { unsigned _sp = 0; while (cond) { __builtin_amdgcn_s_sleep(1); \
    if ((++_sp & 255u) == 0u) { if (xb_ld(&(bar)[XB_TMO])) break; if (_sp > XB_SPIN_CAP) { atomicAdd(&(bar)[XB_TMO], 1u); break; } } } } while (0)

struct XcdBarrier {
    unsigned* bar; unsigned x;
    volatile LAS unsigned* st;
};

__device__ __forceinline__ XcdBarrier xcd_barrier_post(unsigned* bar, volatile LAS unsigned* st) {
    XcdBarrier b; b.bar = bar; b.x = xb_xcc_id(); b.st = st;
    if (threadIdx.x == 0) (void)xb_add(&bar[XB_XCNT(b.x)], 1u);
    return b;
}
__device__ __forceinline__ void xcd_barrier_complete(unsigned* bar, unsigned x, unsigned& nloc, unsigned& nx) {
    const unsigned G = gridDim.x * gridDim.y * gridDim.z;
    unsigned sum, cnt, mine, sp = 0u;
    for (;;) {
        sum = 0u; cnt = 0u; mine = 0u;
#pragma unroll
        for (unsigned j = 0; j < 16; ++j) { const unsigned c = xb_ld(&bar[XB_XCNT(j)]); sum += c; cnt += (c > 0u) ? 1u : 0u; mine = (j == x) ? c : mine; }
        if (sum == G) break;
        __builtin_amdgcn_s_sleep(1);
        if ((++sp & 255u) == 0u) { if (xb_ld(&bar[XB_TMO])) break; if (sp > XB_SPIN_CAP) { atomicAdd(&bar[XB_TMO], 1u); break; } }
    }
    nloc = mine > 0u ? mine : 1u; nx = cnt > 0u ? cnt : 1u;
}

__device__ __forceinline__ void xcd_barrier(const XcdBarrier& b) {
    asm volatile("s_waitcnt vmcnt(0)" ::: "memory");
    __syncthreads();
    if (threadIdx.x == 0) {
        unsigned* bar = b.bar;
        __builtin_amdgcn_s_waitcnt(0);
        unsigned nloc = b.st[0], nx = b.st[1];
        if (nloc == 0u) { xcd_barrier_complete(bar, b.x, nloc, nx); b.st[0] = nloc; b.st[1] = nx; }
        const unsigned old = xb_add(&bar[XB_XSUB(b.x)], 1u);
        const unsigned gen = old / nloc;
        if (old + 1u == (gen + 1u) * nloc) {
            __builtin_amdgcn_fence(__ATOMIC_RELEASE, "agent");
            asm volatile("s_waitcnt vmcnt(0)" ::: "memory");
            const unsigned og = xb_add(&bar[XB_TOP], 1u);
            const unsigned tg = og / nx;
            if (og + 1u == (tg + 1u) * nx) xb_add(&bar[XB_TOPGEN], 1u);
            else XB_SPIN(xb_ld(&bar[XB_TOPGEN]) == tg, bar);
            __builtin_amdgcn_fence(__ATOMIC_ACQUIRE, "agent");
            xb_add(&bar[XB_XGEN(b.x)], 1u);
            asm volatile("s_waitcnt vmcnt(0)" ::: "memory");
        } else {
            XB_SPIN(xb_ld(&bar[XB_XGEN(b.x)]) == gen, bar);
            __builtin_amdgcn_fence(__ATOMIC_ACQUIRE, "agent");
            asm volatile("s_waitcnt vmcnt(0)" ::: "memory");
        }
    }
    __syncthreads();
}

template <int PH>
DI void run_all(const Params& p, unsigned char* lds, cg::grid_group& grid, const XcdBarrier& xb) {
    if constexpr ((PHMASK >> PH) & 1) run_phase<PH>(p, lds);
    if constexpr ((REPMASK >> PH) & 1) { xcd_barrier(xb); run_phase<PH>(p, lds); }
    if constexpr (PH + 1 < NPHASE) {
        if constexpr (PH != 4) xcd_barrier(xb);
        run_all<PH + 1>(p, lds, grid, xb);
    }
}
__global__ void __launch_bounds__(NTHR) mega_kernel(Params p) {
    extern __shared__ __attribute__((aligned(16))) unsigned char lds[];
    cg::grid_group grid = cg::this_grid();
    volatile LAS unsigned* st = (volatile LAS unsigned*)((LAS unsigned char*)lds + 155648);
    if (threadIdx.x < 2) st[threadIdx.x] = 0u;
    __syncthreads();
    const XcdBarrier xb = xcd_barrier_post((unsigned*)(p.ws + O_BARCTR), st);
    if (p.out == nullptr) grid.sync();
    run_all<0>(p, lds, grid, xb);
}
#else
template <int PH>
__global__ void __launch_bounds__(NTHR) phase_kernel(Params p) {
    extern __shared__ __attribute__((aligned(16))) unsigned char lds[];
    run_phase<PH>(p, lds);
}
template <int PH>
static void launch_phases(const Params& p, int grid, hipStream_t stream, bool setattr) {
    if (setattr) (void)hipFuncSetAttribute((const void*)phase_kernel<PH>, hipFuncAttributeMaxDynamicSharedMemorySize, LDS_BYTES);
    else hipLaunchKernelGGL(phase_kernel<PH>, dim3(grid), dim3(NTHR), LDS_BYTES, stream, p);
    if constexpr (PH + 1 < NPHASE) launch_phases<PH + 1>(p, grid, stream, setattr);
}
#endif

extern "C" void kernel_launch(void* const* d_in, const int* in_sizes, int n_in, void* d_out, int out_size, void* d_ws, size_t ws_size, hipStream_t stream) {
    if (n_in != 26 || ws_size < WS_NEED) { fprintf(stderr, "kernel_launch: bad args n_in=%d ws=%zu need=%zu\n", n_in, ws_size, (size_t)WS_NEED); return; }
    Params p{};
    const float** pp = (const float**)&p;
    for (int i = 0; i < 26; ++i) pp[i] = (const float*)d_in[i];
    p.out = (float*)d_out; p.ws = (unsigned char*)d_ws;
    static int grid = 0;
#if MEGA
    if (!grid) {
        int dev = 0, cus = 0, per_cu = 0;
        (void)hipGetDevice(&dev);
        (void)hipDeviceGetAttribute(&cus, hipDeviceAttributeMultiprocessorCount, dev);
        (void)hipFuncSetAttribute((const void*)mega_kernel, hipFuncAttributeMaxDynamicSharedMemorySize, LDS_BYTES);
        (void)hipOccupancyMaxActiveBlocksPerMultiprocessor(&per_cu, (const void*)mega_kernel, NTHR, LDS_BYTES);
        if (per_cu < 1) per_cu = 1;
        grid = cus * 1;
        (void)per_cu;
    }
    (void)hipMemsetAsync((char*)d_ws + O_BARCTR, 0, XCD_BAR_WORDS * 4, stream);
    void* args[] = {(void*)&p};
    hipError_t e = hipLaunchCooperativeKernel((const void*)mega_kernel, dim3(grid), dim3(NTHR), args, LDS_BYTES, stream);
    if (e != hipSuccess) fprintf(stderr, "cooperative launch failed: %s (grid %d)\n", hipGetErrorString(e), grid);
#else
    if (!grid) {
        int dev = 0, cus = 0;
        (void)hipGetDevice(&dev);
        (void)hipDeviceGetAttribute(&cus, hipDeviceAttributeMultiprocessorCount, dev);
        grid = cus;
        launch_phases<0>(p, grid, stream, true);
    }
    launch_phases<0>(p, grid, stream, false);
#endif
}
```
